# Optimizing an MI355X kernel written in HIP

```python
import math
import jax, jax.numpy as jnp
from jax import lax
import numpy as np

D_MODEL = 2048
BATCH = 2
SEQ = 4096
DEPTH = 1

GRID_W = 64
CTX_LEN = 256
RET_HEADS = 4
RET_HEAD_DIM = 256
RET_WIDTH = RET_HEADS * RET_HEAD_DIM
NA_HEADS = 8
NA_HEAD_DIM = 128
NA_WIDTH = NA_HEADS * NA_HEAD_DIM
MIX_WIDTH = RET_WIDTH + NA_WIDTH
IN_PROJ_WIDTH = 4 * RET_WIDTH + 3 * NA_WIDTH
RET_CHUNK = 128
NA_ROWS = 8
NA_COLS = 16
ROPE_BASE = 10000.0
N_GROUPS = 4
EXPERTS_PER_GROUP = 8
N_EXPERTS = N_GROUPS * EXPERTS_PER_GROUP
TOP_K_EXPERTS = 2
EXPERT_FF = 512
N_MOD = 6
NORM_EPS = 1e-6

kernel_name = "hymba_style_retention_natten_hmoe_dit"


def rmsnorm(x, w):
    xf = x.astype(jnp.float32)
    y = xf * lax.rsqrt(jnp.mean(xf * xf, axis=-1, keepdims=True) + NORM_EPS)
    return (y * w.astype(jnp.float32)).astype(x.dtype)


def modulate(h, shift, scale):
    return h * (1.0 + scale) + shift


def heads(t, n_heads):
    return t.reshape(t.shape[:-1] + (n_heads, t.shape[-1] // n_heads))


def bhnd(t):
    return jnp.swapaxes(t, 1, 2).astype(jnp.float32)


def split_proj(p):
    cuts = [RET_WIDTH, 2 * RET_WIDTH, 3 * RET_WIDTH, 4 * RET_WIDTH,
            4 * RET_WIDTH + NA_WIDTH, 4 * RET_WIDTH + 2 * NA_WIDTH]
    return jnp.split(p, cuts, axis=-1)


def rope_1d(x, pos):
    d = x.shape[-1]
    inv = ROPE_BASE ** (-jnp.arange(0, d, 2, dtype=jnp.float32) / d)
    ang = pos.astype(jnp.float32)[:, None] * inv[None, :]
    cos = jnp.cos(ang)[None, :, None, :]
    sin = jnp.sin(ang)[None, :, None, :]
    x1, x2 = x[..., : d // 2], x[..., d // 2:]
    return jnp.concatenate([x1 * cos - x2 * sin, x1 * sin + x2 * cos], axis=-1).astype(x.dtype)


def rope_2d(x, rows, cols):
    half = x.shape[-1] // 2
    return jnp.concatenate([rope_1d(x[..., :half], rows), rope_1d(x[..., half:], cols)], axis=-1)


def retention_chunked(q, k, v, log_gamma, state0):
    b, h, n, _ = q.shape
    dv = v.shape[-1]
    nc = n // RET_CHUNK
    pos = jnp.arange(RET_CHUNK, dtype=jnp.float32)
    diff = pos[:, None] - pos[None, :]
    lg = log_gamma[:, None, None]
    intra = jnp.where(diff >= 0, jnp.exp(lg * jnp.maximum(diff, 0.0)), 0.0)
    q_dec = jnp.exp(log_gamma[:, None] * (pos + 1.0))[..., None]
    k_dec = jnp.exp(log_gamma[:, None] * (RET_CHUNK - 1.0 - pos))[..., None]
    c_dec = jnp.exp(log_gamma * RET_CHUNK)[:, None, None]

    def chunks(t):
        return jnp.moveaxis(t.reshape(b, h, nc, RET_CHUNK, t.shape[-1]), 2, 0)

    def step(state, qkv):
        qi, ki, vi = qkv
        scores = jnp.einsum('bhid,bhjd->bhij', qi, ki) * intra
        out = (jnp.einsum('bhij,bhjv->bhiv', scores, vi)
               + jnp.einsum('bhid,bhdv->bhiv', qi * q_dec, state))
        state = state * c_dec + jnp.einsum('bhjd,bhjv->bhdv', ki * k_dec, vi)
        return state, out

    state, out = lax.scan(step, state0, (chunks(q), chunks(k), chunks(v)))
    return jnp.moveaxis(out, 0, 2).reshape(b, h, n, dv), state


def retention_bidir(q, k, v, lg_f, lg_b, s0_f, s0_b):
    o_f, s_f = retention_chunked(q, k, v, lg_f, s0_f)
    o_b, s_b = retention_chunked(jnp.flip(q, 2), jnp.flip(k, 2), jnp.flip(v, 2), lg_b, s0_b)
    return o_f + jnp.flip(o_b, 2), s_f, s_b


def retention_final_state(k, v, log_gamma, reverse):
    n = k.shape[2]
    pos = jnp.arange(n, dtype=jnp.float32)
    expo = pos if reverse else (n - 1.0 - pos)
    w = jnp.exp(log_gamma[:, None] * expo)[..., None]
    return jnp.einsum('bhjd,bhjv->bhdv', k * w, v)


def retention_output(o, gn_w, g):
    b, h, n, dv = o.shape
    mu = jnp.mean(o, axis=-1, keepdims=True)
    var = jnp.mean(jnp.square(o - mu), axis=-1, keepdims=True)
    o = (o - mu) * lax.rsqrt(var + NORM_EPS) * gn_w.astype(jnp.float32).reshape(h, 1, dv)
    o = jnp.swapaxes(o, 1, 2).reshape(b, n, h * dv)
    return (o * jax.nn.silu(g.astype(jnp.float32))).astype(g.dtype)


def neighbourhood_attention(q, k, v, kc, vc, rpb):
    b, n, h, d = q.shape
    rows = n // GRID_W
    win_r = min(NA_ROWS, rows)
    n_keys = win_r * NA_COLS
    scale = d ** -0.5
    qg = (q * scale).reshape(b, rows, GRID_W, h, d)
    kg = k.reshape(b, rows, GRID_W, h, d)
    vg = v.reshape(b, rows, GRID_W, h, d)
    kc_s = kc
    col = jnp.arange(GRID_W)
    col_start = jnp.clip(col - NA_COLS // 2, 0, GRID_W - NA_COLS)
    col_idx = col_start[:, None] + jnp.arange(NA_COLS)[None, :]
    col_off = col_idx - col[:, None] + (NA_COLS - 1)

    def gather_window(t, rs):
        band = lax.dynamic_slice_in_dim(t, rs, win_r, axis=1)
        win = band[:, :, col_idx]
        return jnp.moveaxis(win, 1, 2).reshape(b, GRID_W, n_keys, h, d)

    def row_fn(r):
        rs = jnp.clip(r - NA_ROWS // 2, 0, rows - win_r)
        qr = lax.dynamic_index_in_dim(qg, r, axis=1, keepdims=False)
        kw = gather_window(kg, rs)
        vw = gather_window(vg, rs)
        row_off = rs + jnp.arange(win_r) - r + (NA_ROWS - 1)
        bias = rpb[:, row_off[:, None, None], col_off[None, :, :]]
        bias = jnp.moveaxis(bias, 1, 2).reshape(h, GRID_W, n_keys)
        s_win = jnp.einsum('bqhd,bqkhd->bhqk', qr, kw) + bias[None]
        s_ctx = jnp.einsum('bqhd,bkhd->bhqk', qr, kc_s)
        p = jax.nn.softmax(jnp.concatenate([s_win, s_ctx], axis=-1).astype(jnp.float32), axis=-1).astype(v.dtype)
        return (jnp.einsum('bhqk,bqkhd->bqhd', p[..., :n_keys], vw)
                + jnp.einsum('bhqk,bkhd->bqhd', p[..., n_keys:], vc))

    out = lax.map(row_fn, jnp.arange(rows))
    return jnp.moveaxis(out, 0, 1).reshape(b, n, h * d)


def context_attention(q, k, v):
    b, l, h, d = q.shape
    s = jnp.einsum('bqhd,bkhd->bhqk', q * d ** -0.5, k)
    p = jax.nn.softmax(s.astype(jnp.float32), axis=-1).astype(v.dtype)
    return jnp.einsum('bhqk,bkhd->bqhd', p, v).reshape(b, l, h * d)


def hierarchical_moe(h, w_rg, b_rg, w_re, b_re, w_gate, w_up, w_down):
    g_logits = (h @ w_rg + b_rg).astype(jnp.float32)
    g_prob = jax.nn.softmax(g_logits, axis=-1)
    g_sel = jnp.argmax(g_logits, axis=-1)
    g_w = jnp.take_along_axis(g_prob, g_sel[:, None], axis=-1)
    e_logits = (jnp.einsum('td,gde->tge', h, w_re) + b_re).astype(jnp.float32)
    e_logits = jnp.take_along_axis(e_logits, g_sel[:, None, None], axis=1)[:, 0]
    top_v, top_i = lax.top_k(e_logits, TOP_K_EXPERTS)
    e_w = jax.nn.softmax(top_v, axis=-1) * g_w
    expert_id = g_sel[:, None] * EXPERTS_PER_GROUP + top_i
    combine = jnp.sum(jax.nn.one_hot(expert_id, N_EXPERTS, dtype=jnp.float32) * e_w[..., None], axis=1)
    combine = combine.astype(h.dtype)
    out = jnp.zeros_like(h)
    for e in range(N_EXPERTS):
        a = jax.nn.silu(h @ w_gate[e]) * (h @ w_up[e])
        out = out + combine[:, e:e + 1] * (a @ w_down[e])
    return out


def trunk_layer(x, xc, c, c_ctx, w_mod, b_mod, norm_mix_w, w_in, ret_decay_f, ret_decay_b,
                ret_gn_w, na_rpb, w_out, norm_ffn_w, w_rg, b_rg, w_re, b_re,
                w_gate, w_up, w_down, last):
    b, n, d_model = x.shape
    mod = jax.nn.silu(c) @ w_mod + b_mod
    sh_a, sc_a, g_a, sh_f, sc_f, g_f = [m[:, None, :] for m in jnp.split(mod, N_MOD, axis=-1)]
    mod_c = jax.nn.silu(c_ctx) @ w_mod + b_mod
    csh_a, csc_a, cg_a, csh_f, csc_f, cg_f = jnp.split(mod_c, N_MOD, axis=-1)

    hx = modulate(rmsnorm(x, norm_mix_w), sh_a, sc_a)
    hc = modulate(rmsnorm(xc, norm_mix_w), csh_a, csc_a)
    rq, rk, rv, rg, nq, nk, nv = split_proj(hx @ w_in)
    crq, crk, crv, crg, cnq, cnk, cnv = split_proj(hc @ w_in)

    t = jnp.arange(n)
    rows_pos, cols_pos = t // GRID_W, t % GRID_W
    lg_f = jax.nn.log_sigmoid(ret_decay_f.astype(jnp.float32))
    lg_b = jax.nn.log_sigmoid(ret_decay_b.astype(jnp.float32))
    k_scale = RET_HEAD_DIM ** -0.5

    ck = bhnd(heads(crk, RET_HEADS)) * k_scale
    cv = bhnd(heads(crv, RET_HEADS))
    if last:
        s_f = retention_final_state(ck, cv, lg_f, False)
        s_b = retention_final_state(ck, cv, lg_b, True)
    else:
        zeros = jnp.zeros((b, RET_HEADS, RET_HEAD_DIM, RET_HEAD_DIM), jnp.float32)
        oc, s_f, s_b = retention_bidir(bhnd(heads(crq, RET_HEADS)), ck, cv, lg_f, lg_b, zeros, zeros)
    q = bhnd(rope_2d(heads(rq, RET_HEADS), rows_pos, cols_pos))
    k = bhnd(rope_2d(heads(rk, RET_HEADS), rows_pos, cols_pos)) * k_scale
    v = bhnd(heads(rv, RET_HEADS))
    o, _, _ = retention_bidir(q, k, v, lg_f, lg_b, s_f, s_b)
    ret_x = retention_output(o, ret_gn_w, rg)

    kc_na = heads(cnk, NA_HEADS)
    vc_na = heads(cnv, NA_HEADS)
    na_x = neighbourhood_attention(heads(nq, NA_HEADS), heads(nk, NA_HEADS), heads(nv, NA_HEADS),
                                   kc_na, vc_na, na_rpb)
    x = x + g_a * (jnp.concatenate([ret_x, na_x], axis=-1) @ w_out)

    if not last:
        ret_c = retention_output(oc, ret_gn_w, crg)
        na_c = context_attention(heads(cnq, NA_HEADS), kc_na, vc_na)
        xc = xc + cg_a * (jnp.concatenate([ret_c, na_c], axis=-1) @ w_out)
        hcf = modulate(rmsnorm(xc, norm_ffn_w), csh_f, csc_f)
        xc = xc + cg_f * hierarchical_moe(hcf.reshape(-1, d_model), w_rg, b_rg, w_re, b_re,
                                          w_gate, w_up, w_down).reshape(xc.shape)

    hf = modulate(rmsnorm(x, norm_ffn_w), sh_f, sc_f)
    x = x + g_f * hierarchical_moe(hf.reshape(-1, d_model), w_rg, b_rg, w_re, b_re,
                                   w_gate, w_up, w_down).reshape(x.shape)
    return x, xc


def setup_inputs(seed: int = 0) -> dict:
    key = jax.random.key(seed)
    ks = jax.random.split(key, 24)
    D = D_MODEL
    nrm = jax.random.normal
    ladder = jnp.log(2.0 ** (5.0 + jnp.arange(RET_HEADS, dtype=jnp.float32)) - 1.0)
    return {
        "x": nrm(ks[0], (BATCH, SEQ, D), jnp.float32),
        "c": nrm(ks[1], (BATCH, D), jnp.float32),
        "ctx": nrm(ks[2], (BATCH, CTX_LEN, D), jnp.float32),
        "c_ctx": nrm(ks[3], (D,), jnp.float32),
        "w_mod": nrm(ks[4], (DEPTH, D, N_MOD * D), jnp.float32) * (0.5 * D ** -0.5),
        "b_mod": nrm(ks[5], (DEPTH, N_MOD * D), jnp.float32) * 0.01,
        "norm_mix_w": 1.0 + 0.05 * nrm(ks[6], (DEPTH, D), jnp.float32),
        "w_in": nrm(ks[7], (DEPTH, D, IN_PROJ_WIDTH), jnp.float32) * D ** -0.5,
        "ret_decay_f": ladder + 0.05 * nrm(ks[8], (DEPTH, RET_HEADS), jnp.float32),
        "ret_decay_b": ladder + 0.05 * nrm(ks[9], (DEPTH, RET_HEADS), jnp.float32),
        "ret_gn_w": 1.0 + 0.05 * nrm(ks[10], (DEPTH, RET_WIDTH), jnp.float32),
        "na_rpb": 0.1 * nrm(ks[11], (DEPTH, NA_HEADS, 2 * NA_ROWS - 1, 2 * NA_COLS - 1), jnp.float32),
        "w_out": nrm(ks[12], (DEPTH, MIX_WIDTH, D), jnp.float32) * MIX_WIDTH ** -0.5,
        "norm_ffn_w": 1.0 + 0.05 * nrm(ks[13], (DEPTH, D), jnp.float32),
        "w_router_group": nrm(ks[14], (DEPTH, D, N_GROUPS), jnp.float32) * D ** -0.5,
        "b_router_group": 0.01 * nrm(ks[15], (DEPTH, N_GROUPS), jnp.float32),
        "w_router_expert": nrm(ks[16], (DEPTH, N_GROUPS, D, EXPERTS_PER_GROUP), jnp.float32) * D ** -0.5,
        "b_router_expert": 0.01 * nrm(ks[17], (DEPTH, N_GROUPS, EXPERTS_PER_GROUP), jnp.float32),
        "w_gate": nrm(ks[18], (DEPTH, N_EXPERTS, D, EXPERT_FF), jnp.float32) * D ** -0.5,
        "w_up": nrm(ks[19], (DEPTH, N_EXPERTS, D, EXPERT_FF), jnp.float32) * D ** -0.5,
        "w_down": nrm(ks[20], (DEPTH, N_EXPERTS, EXPERT_FF, D), jnp.float32) * EXPERT_FF ** -0.5,
        "final_norm_w": 1.0 + 0.05 * nrm(ks[21], (D,), jnp.float32),
    }


def reference(x, c, ctx, c_ctx, w_mod, b_mod, norm_mix_w, w_in, ret_decay_f, ret_decay_b,
              ret_gn_w, na_rpb, w_out, norm_ffn_w, w_router_group, b_router_group,
              w_router_expert, b_router_expert, w_gate, w_up, w_down, final_norm_w):
    xc = ctx
    for l in range(DEPTH):
        x, xc = trunk_layer(x, xc, c, c_ctx, w_mod[l], b_mod[l], norm_mix_w[l], w_in[l],
                            ret_decay_f[l], ret_decay_b[l], ret_gn_w[l], na_rpb[l], w_out[l],
                            norm_ffn_w[l], w_router_group[l], b_router_group[l],
                            w_router_expert[l], b_router_expert[l], w_gate[l], w_up[l], w_down[l],
                            last=(l == DEPTH - 1))
    return rmsnorm(x, final_norm_w)
```

```cpp
#include <hip/hip_runtime.h>
#include <cstdio>
#include <cstdint>

#define LAS __attribute__((address_space(3)))
#define GAS __attribute__((address_space(1)))
typedef unsigned short bf16_t;
typedef short bf16x8 __attribute__((ext_vector_type(8)));
typedef short s16x4 __attribute__((ext_vector_type(4)));
typedef float f32x4 __attribute__((ext_vector_type(4)));
typedef float f32x2 __attribute__((ext_vector_type(2)));
typedef unsigned u32x4 __attribute__((ext_vector_type(4)));
typedef unsigned u32x2 __attribute__((ext_vector_type(2)));

#ifndef PHASES
#define PHASES 0xFFFF
#endif
#ifndef REP
#define REP 0
#endif
#ifndef DBG_MODE
#define DBG_MODE 0
#endif

constexpr int DM = 2048, SEQ = 4096, MTOK = 8192, CTXL = 256, MALL = 8704, NIN = 7168;
constexpr int LDT = 4352;
constexpr int NEXP = 32, FF = 512, MAXSLOT = 24576;
constexpr float NORM_EPS = 1e-6f;
constexpr float LOG2E = 1.4426950408889634f;

constexpr size_t MiB = 1u << 20;
constexpr size_t WS_CTL = 0, CTL_ZERO_BYTES = 65536;
constexpr size_t WS_MOD = 1 * MiB;
constexpr size_t WS_TOK = 2 * MiB;
constexpr size_t WS_WSLOT = 2 * MiB + 512 * 1024;
constexpr size_t WS_S2T = 3 * MiB;
constexpr size_t WS_WRT = 3 * MiB + 512 * 1024;
constexpr size_t WS_WIN = 4 * MiB, WS_WOUT = 32 * MiB, WS_WGU = 40 * MiB, WS_WD = 168 * MiB, WS_X1 = 232 * MiB;
constexpr size_t WS_E = 296 * MiB;
constexpr size_t WS_HX = WS_E, WS_Q = WS_E + 34 * MiB, WS_K = WS_E + 50 * MiB, WS_G = WS_E + 66 * MiB, WS_NQ = WS_E + 82 * MiB, WS_NK = WS_E + 98 * MiB;
constexpr size_t WS_KTF = WS_E + 115 * MiB, WS_KTB = WS_E + 132 * MiB, WS_NVT = WS_E + 149 * MiB;
constexpr size_t WS_SV = WS_E + 166 * MiB;
constexpr size_t WS_SVC = WS_E + 214 * MiB;
constexpr size_t WS_QP = WS_E + 217 * MiB;
constexpr size_t WS_MIX = WS_E + 265 * MiB;
constexpr size_t WS_HF = WS_E, WS_HFS = WS_E + 32 * MiB, WS_ACT = WS_E + 128 * MiB, WS_Y = WS_E + 152 * MiB;
constexpr size_t WS_END = WS_E + 297 * MiB;
constexpr int CW_BAR = 4096, CW_CNT = 8192, CW_MODRDY = 12288;

constexpr int RING_BYTES = 131072, CTL_OFF = 161792, MISC_OFF = CTL_OFF + 320, TEXP_OFF = CTL_OFF + 1024, LDS_BYTES = 163840;
constexpr int NWAVES = 8;

__device__ __forceinline__ unsigned cvt_pk_bf16(float lo, float hi) { unsigned r; asm volatile("v_cvt_pk_bf16_f32 %0, %1, %2" : "=v"(r) : "v"(lo), "v"(hi)); return r; }
typedef int v8i __attribute__((ext_vector_type(8)));
typedef int v4i __attribute__((ext_vector_type(4)));
constexpr float W8_SCALE = 64.0f, A8_SCALE = 8.0f, MIX8_SCALE = 16.0f;
__device__ __forceinline__ u32x2 cvt8_fp8(const float (&h)[8]) { int lo = __builtin_amdgcn_cvt_pk_fp8_f32(h[0], h[1], 0, false); lo = __builtin_amdgcn_cvt_pk_fp8_f32(h[2], h[3], lo, true);
    int hi = __builtin_amdgcn_cvt_pk_fp8_f32(h[4], h[5], 0, false); hi = __builtin_amdgcn_cvt_pk_fp8_f32(h[6], h[7], hi, true); u32x2 r; r.x = (unsigned)lo; r.y = (unsigned)hi; return r; }
__device__ __forceinline__ float bf2f(unsigned short h) { return __uint_as_float((unsigned)h << 16); }
__device__ __forceinline__ float bflo(unsigned w) { return __uint_as_float(w << 16); }
__device__ __forceinline__ float bfhi(unsigned w) { return __uint_as_float(w & 0xffff0000u); }
template <int X> __device__ __forceinline__ float lane_xor(float v) { return __int_as_float(__builtin_amdgcn_ds_swizzle(__float_as_int(v), (X << 10) | 0x1f)); }
__device__ __forceinline__ float half_sum(float v) { const auto r = __builtin_amdgcn_permlane32_swap(__float_as_uint(v), __float_as_uint(v), false, false); return __uint_as_float(r[0]) + __uint_as_float(r[1]); }
__device__ __forceinline__ float half_max(float v) { const auto r = __builtin_amdgcn_permlane32_swap(__float_as_uint(v), __float_as_uint(v), false, false); return fmaxf(__uint_as_float(r[0]), __uint_as_float(r[1])); }
__device__ __forceinline__ float sum_g4(float v) { v += lane_xor<16>(v); return half_sum(v); }
__device__ __forceinline__ float max_g4(float v) { v = fmaxf(v, lane_xor<16>(v)); return half_max(v); }
__device__ __forceinline__ float wave_sum(float v) { v += lane_xor<1>(v); v += lane_xor<2>(v); v += lane_xor<4>(v); v += lane_xor<8>(v); v += lane_xor<16>(v); return half_sum(v); }
__device__ __forceinline__ float silu_f(float x) { return x * __builtin_amdgcn_rcpf(1.0f + __expf(-x)); }
__device__ __forceinline__ void sincos_ang(float ang, float& s, float& c) { float rev = ang * 0.15915494309189535f; rev = rev - floorf(rev); s = __builtin_amdgcn_sinf(rev); c = __builtin_amdgcn_cosf(rev); }
__device__ __forceinline__ float log2_sigmoid(float x) { return -log1pf(__expf(-x)) * LOG2E; }
#define LDS_WAIT() asm volatile("s_waitcnt lgkmcnt(0)" ::: "memory")
#define VM_WAIT() asm volatile("s_waitcnt vmcnt(0)" ::: "memory")

namespace pg8 {
constexpr int BM = 256, BK = 64, HALF = 128, HTB = HALF * BK * 2, STAGE_BYTES = 8 * HTB;
__device__ __forceinline__ int lds_byte(int r, int c) { const int st = (r >> 4) * 2 + (c >> 5), rr = r & 15, cc = c & 31, ob = rr * 64 + cc * 2; return st * 1024 + (ob ^ (((ob >> 9) & 1) << 5)); }
__device__ __forceinline__ void stage_rc(int b, int& R, int& C) { const int st = b / 1024, sb = b % 1024, swz = sb ^ (((sb >> 9) & 1) << 5); R = (st >> 1) * 16 + swz / 64; C = (st & 1) * 32 + (swz % 64) / 2; }
__device__ __forceinline__ int perm32(int rho) { const int n = rho >> 4, i = rho & 15; return 8 * (i >> 2) + 4 * n + (i & 3); }

struct Unit { const char* a; const char* b; int i0, i1, i2, i3; };

template <class Epi, class Sched, bool ALIGN_EPI, int MX = 0>
__device__ __forceinline__ void gemm_phase(LAS unsigned char* lds, const int wid, const int lda, const int ldb, const int K, const Sched& S, const Epi& E) {
    int lane; asm volatile("v_mbcnt_lo_u32_b32 %0, -1, 0\n\tv_mbcnt_hi_u32_b32 %0, -1, %0" : "=v"(lane));
    const int tid = wid * 64 + lane, wr = wid >> 2, wc = wid & 3, fr = lane & 15, fq = lane >> 4;
    const int nt = K / BK;
    unsigned voffA[2], voffB[2]; int RA[2], CA[2];
#pragma unroll
    for (int i = 0; i < 2; ++i) { int R, C; stage_rc(tid * 16 + i * 8192, R, C); const int Rb = Epi::PERM ? ((R & ~31) + perm32(R & 31)) : R; RA[i] = R; CA[i] = C;
        voffA[i] = (unsigned)(R * lda + C) * 2u; voffB[i] = (unsigned)(Rb * ldb + C) * 2u; }
    unsigned gc0[2] = {0u, 0u}, gc1[2] = {0u, 0u}, gn0[2] = {0u, 0u}, gn1[2] = {0u, 0u};
    const size_t kstep = (size_t)(BK * 2);
    const size_t hstepA = Sched::GATHER ? (size_t)0 : (size_t)HALF * lda * 2, hstepB = (size_t)HALF * ldb * 2;
    const unsigned ldsw = (unsigned)wid * 1024u;
    const int aoff = lds_byte(wr * 64 + fr, fq * 8), boff = lds_byte(wc * 32 + fr, fq * 8);
#define PG8_SA(b, h) (((b) * 2 + (h)) * HTB)
#define PG8_SB(b, h) ((4 + (b) * 2 + (h)) * HTB)
#define PG8_STAGE(bufoff, gbase, voff) do { _Pragma("unroll") for (int _i = 0; _i < 2; ++_i) \
        __builtin_amdgcn_global_load_lds((const unsigned*)((const char*)(gbase) + (voff)[_i]), (LAS unsigned*)(lds + (bufoff) + ldsw + _i * 8192), 16, 0, 0); } while (0)
#define PG8_LDS16(off) (*(const LAS v4i*)(lds + (off)))
#define PG8_LDA(dst, b, h) do { if constexpr (MX == 0) { _Pragma("unroll") for (int m = 0; m < 4; ++m) _Pragma("unroll") for (int k = 0; k < 2; ++k) dst[m][k] = *(const LAS bf16x8*)(lds + PG8_SA(b, h) + aoff + m * 2048 + k * 1024); } \
        else { _Pragma("unroll") for (int m = 0; m < 4; ++m) dst##8[m] = __builtin_shufflevector(PG8_LDS16(PG8_SA(b, h) + aoff + m * 2048), PG8_LDS16(PG8_SA(b, h) + aoff + m * 2048 + 1024), 0, 1, 2, 3, 4, 5, 6, 7); } } while (0)
#define PG8_LDB(dst, b, h) do { if constexpr (MX == 0) { _Pragma("unroll") for (int n = 0; n < 2; ++n) _Pragma("unroll") for (int k = 0; k < 2; ++k) dst[n][k] = *(const LAS bf16x8*)(lds + PG8_SB(b, h) + boff + n * 2048 + k * 1024); } \
        else { _Pragma("unroll") for (int n = 0; n < 2; ++n) dst##8[n] = __builtin_shufflevector(PG8_LDS16(PG8_SB(b, h) + boff + n * 2048), PG8_LDS16(PG8_SB(b, h) + boff + n * 2048 + 1024), 0, 1, 2, 3, 4, 5, 6, 7); } } while (0)
#define PG8_MMA(ai, bj, At, Bt) do { __builtin_amdgcn_s_setprio(1); if constexpr (MX == 0) { _Pragma("unroll") for (int m = 0; m < 4; ++m) _Pragma("unroll") for (int n = 0; n < 2; ++n) _Pragma("unroll") for (int k = 0; k < 2; ++k) \
        acc[ai][bj][m][n] = __builtin_amdgcn_mfma_f32_16x16x32_bf16(Bt[n][k], At[m][k], acc[ai][bj][m][n], 0, 0, 0); } else { _Pragma("unroll") for (int m = 0; m < 4; ++m) _Pragma("unroll") for (int n = 0; n < 2; ++n) \
        asm volatile("v_mfma_scale_f32_16x16x128_f8f6f4 %0, %1, %2, %0, %3, %3 op_sel_hi:[0,0,0]" : "+v"(acc[ai][bj][m][n]) : "v"(Bt##8[n]), "v"(At##8[m]), "v"(mxs1)); } \
        __builtin_amdgcn_s_setprio(0); } while (0)
#define PG8_WAIT_V(n) asm volatile("s_waitcnt vmcnt(" #n ")" ::: "memory")
#define PG8_WAIT_L(n) asm volatile("s_waitcnt lgkmcnt(" #n ")" ::: "memory")
#define PG8_BAR __builtin_amdgcn_s_barrier()
#define PG8_SCHED __builtin_amdgcn_sched_barrier(0)
    Unit cur, nxt; int ui = 0;
    if (!S.next(0, cur)) return;
    f32x4 acc[2][2][4][2];
#pragma unroll
    for (int a = 0; a < 2; ++a)
#pragma unroll
        for (int b = 0; b < 2; ++b)
#pragma unroll
            for (int m = 0; m < 4; ++m)
#pragma unroll
                for (int n = 0; n < 2; ++n) acc[a][b][m][n] = (f32x4){0.f, 0.f, 0.f, 0.f};
    bf16x8 At[4][2], B0[2][2], B1[2][2];
    v8i At8[4], B08[2], B18[2];
    const int mxs1 = 0x7F7F7F7F;
    const char* cA = cur.a; const char* cB = cur.b;
    if constexpr (Sched::GATHER) S.rows(cur, RA, CA, gc0, gc1);
#define PG8_VA0C (Sched::GATHER ? gc0 : voffA)
#define PG8_VA1C (Sched::GATHER ? gc1 : voffA)
    PG8_STAGE(PG8_SB(0, 0), cB, voffB); PG8_STAGE(PG8_SB(0, 1), cB + hstepB, voffB); PG8_STAGE(PG8_SA(0, 0), cA, PG8_VA0C); PG8_STAGE(PG8_SA(0, 1), cA + hstepA, PG8_VA1C);
    if (wr == 1) PG8_BAR;
    PG8_WAIT_V(2); PG8_BAR;
    PG8_STAGE(PG8_SB(1, 0), cB + kstep, voffB); PG8_STAGE(PG8_SA(1, 0), cA + kstep, PG8_VA0C); PG8_STAGE(PG8_SB(1, 1), cB + hstepB + kstep, voffB);
    PG8_WAIT_V(6); PG8_BAR;
    for (;;) {
        const bool has_next = S.next(ui + 1, nxt);
        const char* nA = has_next ? nxt.a : cA; const char* nB = has_next ? nxt.b : cB;
        if constexpr (Sched::GATHER) { if (has_next) S.rows(nxt, RA, CA, gn0, gn1); else { gn0[0] = gc0[0]; gn0[1] = gc0[1]; gn1[0] = gc1[0]; gn1[1] = gc1[1]; } }
#pragma unroll 1
        for (int t = 0; t < nt; t += 2) {
            const bool last = (t == nt - 2);
            const char* a1 = cA + (size_t)(t + 1) * kstep;
            const char* a2 = last ? nA : cA + (size_t)(t + 2) * kstep; const char* b2 = last ? nB : cB + (size_t)(t + 2) * kstep;
            const char* a3 = a2 + kstep; const char* b3 = b2 + kstep;
            unsigned gs0[2], gs1[2];
            if constexpr (Sched::GATHER) { gs0[0] = last ? gn0[0] : gc0[0]; gs0[1] = last ? gn0[1] : gc0[1]; gs1[0] = last ? gn1[0] : gc1[0]; gs1[1] = last ? gn1[1] : gc1[1]; }
#define PG8_VA0S (Sched::GATHER ? gs0 : voffA)
#define PG8_VA1S (Sched::GATHER ? gs1 : voffA)
            PG8_LDB(B0, 0, 0); PG8_LDB(B1, 0, 1); PG8_SCHED; PG8_LDA(At, 0, 0); PG8_STAGE(PG8_SA(1, 1), a1 + hstepA, PG8_VA1C);
            PG8_WAIT_V(8); PG8_WAIT_L(0); PG8_BAR; PG8_MMA(0, 0, At, B0); PG8_MMA(0, 1, At, B1); PG8_BAR; PG8_SCHED;
            PG8_LDA(At, 0, 1); PG8_STAGE(PG8_SB(0, 0), b2, voffB); PG8_STAGE(PG8_SB(0, 1), b2 + hstepB, voffB); PG8_STAGE(PG8_SA(0, 0), a2, PG8_VA0S);
            PG8_WAIT_V(8); PG8_WAIT_L(0); PG8_BAR; PG8_MMA(1, 0, At, B0); PG8_MMA(1, 1, At, B1); PG8_BAR; PG8_SCHED;
            PG8_LDB(B0, 1, 0); PG8_LDB(B1, 1, 1); PG8_SCHED; PG8_LDA(At, 1, 0); PG8_STAGE(PG8_SA(0, 1), a2 + hstepA, PG8_VA1S);
            PG8_WAIT_V(8); PG8_WAIT_L(0); PG8_BAR; PG8_MMA(0, 0, At, B0); PG8_MMA(0, 1, At, B1); PG8_BAR; PG8_SCHED;
            PG8_LDA(At, 1, 1); PG8_STAGE(PG8_SB(1, 0), b3, voffB); PG8_STAGE(PG8_SB(1, 1), b3 + hstepB, voffB); PG8_STAGE(PG8_SA(1, 0), a3, PG8_VA0S);
            PG8_WAIT_V(8); PG8_WAIT_L(0); PG8_BAR; PG8_MMA(1, 0, At, B0); PG8_MMA(1, 1, At, B1); PG8_BAR; PG8_SCHED;
        }
        if constexpr (MX != 0) asm volatile("s_nop 15\n\ts_nop 15" ::: "memory");
        if constexpr (ALIGN_EPI) { if (wr == 0) PG8_BAR; }
        if constexpr (!Epi::AFTER_DRAIN) E(acc, cur, wr, wc, fr, fq);
        if (!has_next) break;
        float csc = 0.f;
        if constexpr (Epi::CHAIN) csc = E.chain_scale(cur);
        if (csc == 0.f) {
#pragma unroll
            for (int a = 0; a < 2; ++a)
#pragma unroll
                for (int b = 0; b < 2; ++b)
#pragma unroll
                    for (int m = 0; m < 4; ++m)
#pragma unroll
                        for (int n = 0; n < 2; ++n) acc[a][b][m][n] = (f32x4){0.f, 0.f, 0.f, 0.f};
        } else {
#pragma unroll
            for (int a = 0; a < 2; ++a)
#pragma unroll
                for (int b = 0; b < 2; ++b)
#pragma unroll
                    for (int m = 0; m < 4; ++m)
#pragma unroll
                        for (int n = 0; n < 2; ++n) acc[a][b][m][n] = acc[a][b][m][n] * csc;
        }
        cur = nxt; cA = nA; cB = nB; ++ui;
        if constexpr (Sched::GATHER) { gc0[0] = gn0[0]; gc0[1] = gn0[1]; gc1[0] = gn1[0]; gc1[1] = gn1[1]; }
        if constexpr (ALIGN_EPI) { if (wr == 1) PG8_BAR; }
    }
    PG8_WAIT_V(0);
    if constexpr (!ALIGN_EPI) { if (wr == 0) PG8_BAR; }
    PG8_BAR;
    if constexpr (Epi::AFTER_DRAIN) E.fused(acc, cur, wr, wc, fr, fq, lds);
#undef PG8_VA0C
#undef PG8_VA1C
#undef PG8_VA0S
#undef PG8_VA1S
#undef PG8_SA
#undef PG8_SB
#undef PG8_STAGE
#undef PG8_LDA
#undef PG8_LDB
#undef PG8_MMA
#undef PG8_LDS16
#undef PG8_WAIT_V
#undef PG8_WAIT_L
#undef PG8_BAR
#undef PG8_SCHED
}
}

#define XB_TMO      128
#define XB_XCNT(j)  (256  + 64 * (j))
#define XB_XSUB(j)  (1280 + 64 * (j))
#define XB_XGEN(j)  (2304 + 64 * (j))
#define XB_TOP      3328
#define XB_TOPGEN   3392
#define XCD_BAR_WORDS 3456
#define XB_SPIN_CAP (1u << 18)
__device__ __forceinline__ unsigned xb_ld(unsigned* p)              { return __hip_atomic_load(p, __ATOMIC_RELAXED, __HIP_MEMORY_SCOPE_AGENT); }
__device__ __forceinline__ unsigned xb_add(unsigned* p, unsigned v) { return __hip_atomic_fetch_add(p, v, __ATOMIC_RELAXED, __HIP_MEMORY_SCOPE_AGENT); }
__device__ __forceinline__ unsigned xb_xcc_id() { return (unsigned)__builtin_amdgcn_s_getreg((3 << 11) | 20) & 0xFu; }
#define XB_SPIN(cond, bar) do { unsigned _sp = 0; while (cond) { __builtin_amdgcn_s_sleep(1); \
    if ((++_sp & 255u) == 0u) { if (xb_ld(&(bar)[XB_TMO])) break; if (_sp > XB_SPIN_CAP) { atomicAdd(&(bar)[XB_TMO], 1u); break; } } } } while (0)
struct XcdBarrier { unsigned* bar; unsigned x; volatile LAS unsigned* st; };
__device__ __forceinline__ XcdBarrier xcd_barrier_post(unsigned* bar, volatile LAS unsigned* st) {
    XcdBarrier b; b.bar = bar; b.x = xb_xcc_id(); b.st = st;
    if (threadIdx.x == 0) (void)xb_add(&bar[XB_XCNT(b.x)], 1u);
    return b;
}
__device__ __forceinline__ void xcd_barrier_complete(unsigned* bar, unsigned x, unsigned& nloc, unsigned& nx) {
    const unsigned G = gridDim.x * gridDim.y * gridDim.z;
    unsigned sum, cnt, mine, sp = 0u;
    for (;;) {
        sum = 0u; cnt = 0u; mine = 0u;
#pragma unroll
        for (unsigned j = 0; j < 16; ++j) { const unsigned c = xb_ld(&bar[XB_XCNT(j)]); sum += c; cnt += (c > 0u) ? 1u : 0u; mine = (j == x) ? c : mine; }
        if (sum == G) break;
        __builtin_amdgcn_s_sleep(1);
        if ((++sp & 255u) == 0u) { if (xb_ld(&bar[XB_TMO])) break; if (sp > XB_SPIN_CAP) { atomicAdd(&bar[XB_TMO], 1u); break; } }
    }
    nloc = mine > 0u ? mine : 1u; nx = cnt > 0u ? cnt : 1u;
}
__device__ __forceinline__ void xcd_barrier(const XcdBarrier& b) {
    asm volatile("s_waitcnt vmcnt(0)" ::: "memory");
    __syncthreads();
    if (threadIdx.x == 0) {
        unsigned* bar = b.bar;
        __builtin_amdgcn_s_waitcnt(0);
        unsigned nloc = b.st[0], nx = b.st[1];
        if (nloc == 0u) { xcd_barrier_complete(bar, b.x, nloc, nx); b.st[0] = nloc; b.st[1] = nx; }
        const unsigned old = xb_add(&bar[XB_XSUB(b.x)], 1u);
        const unsigned gen = old / nloc;
        if (old + 1u == (gen + 1u) * nloc) {
            __builtin_amdgcn_fence(__ATOMIC_RELEASE, "agent");
            asm volatile("s_waitcnt vmcnt(0)" ::: "memory");
            const unsigned og = xb_add(&bar[XB_TOP], 1u);
            const unsigned tg = og / nx;
            if (og + 1u == (tg + 1u) * nx) xb_add(&bar[XB_TOPGEN], 1u);
            else XB_SPIN(xb_ld(&bar[XB_TOPGEN]) == tg, bar);
            __builtin_amdgcn_fence(__ATOMIC_ACQUIRE, "agent");
            xb_add(&bar[XB_XGEN(b.x)], 1u);
            asm volatile("s_waitcnt vmcnt(0)" ::: "memory");
        } else {
            XB_SPIN(xb_ld(&bar[XB_XGEN(b.x)]) == gen, bar);
            __builtin_amdgcn_fence(__ATOMIC_ACQUIRE, "agent");
            asm volatile("s_waitcnt vmcnt(0)" ::: "memory");
        }
    }
    __syncthreads();
}

struct Params {
    const float *x, *c, *ctx, *c_ctx, *w_mod, *b_mod, *norm_mix_w, *w_in, *ret_decay_f, *ret_decay_b, *ret_gn_w, *na_rpb, *w_out, *norm_ffn_w,
                *w_rg, *b_rg, *w_re, *b_re, *w_gate, *w_up, *w_down, *final_norm_w;
    float* out; unsigned char* ws;
};

template <class RowMap>
__device__ __forceinline__ void conv_item(const float* W, int K, int N, bf16_t* WT, LAS float* scr, int kb, int nb, int lane, RowMap rm) {
    const int k0 = 64 * kb, n0 = 32 * nb;
    f32x4 v[8];
#pragma unroll
    for (int i = 0; i < 8; ++i) { const int kk = 8 * i + (lane >> 3); v[i] = __builtin_nontemporal_load((const f32x4*)(W + (size_t)(k0 + kk) * N + n0 + 4 * (lane & 7))); }
#pragma unroll
    for (int i = 0; i < 8; ++i) { const int kk = 8 * i + (lane >> 3); LAS float* d = scr + kk * 33 + 4 * (lane & 7); d[0] = v[i].x; d[1] = v[i].y; d[2] = v[i].z; d[3] = v[i].w; }
    LDS_WAIT(); asm volatile("" ::: "memory");
    const int c = lane & 7;
#pragma unroll
    for (int j = 0; j < 4; ++j) { const int n = (lane >> 3) + 8 * j; const LAS float* s = scr + (8 * c) * 33 + n;
        u32x4 o; o.x = cvt_pk_bf16(s[0 * 33], s[1 * 33]); o.y = cvt_pk_bf16(s[2 * 33], s[3 * 33]); o.z = cvt_pk_bf16(s[4 * 33], s[5 * 33]); o.w = cvt_pk_bf16(s[6 * 33], s[7 * 33]);
        __builtin_nontemporal_store(o, (u32x4*)(WT + (size_t)rm(n0 + n) * K + k0 + 8 * c)); }
    LDS_WAIT(); asm volatile("" ::: "memory");
}
template <class RowMap>
__device__ __forceinline__ void conv_item8(const float* W, int ldo, int N, unsigned char* WT, LAS float* scr, int kb, int nb, int lane, RowMap rm) {
    const int k0 = 64 * kb, n0 = 32 * nb;
    f32x4 v[8];
#pragma unroll
    for (int i = 0; i < 8; ++i) { const int kk = 8 * i + (lane >> 3); v[i] = __builtin_nontemporal_load((const f32x4*)(W + (size_t)(k0 + kk) * N + n0 + 4 * (lane & 7))); }
#pragma unroll
    for (int i = 0; i < 8; ++i) { const int kk = 8 * i + (lane >> 3); LAS float* d = scr + kk * 33 + 4 * (lane & 7); d[0] = v[i].x; d[1] = v[i].y; d[2] = v[i].z; d[3] = v[i].w; }
    LDS_WAIT(); asm volatile("" ::: "memory");
    const int c = lane & 7;
#pragma unroll
    for (int j = 0; j < 4; ++j) { const int n = (lane >> 3) + 8 * j; const LAS float* s = scr + (8 * c) * 33 + n; float h[8];
#pragma unroll
        for (int e = 0; e < 8; ++e) h[e] = s[e * 33] * W8_SCALE;
        __builtin_nontemporal_store(cvt8_fp8(h), (u32x2*)(WT + (size_t)rm(n0 + n) * ldo + k0 + 8 * c)); }
    LDS_WAIT(); asm volatile("" ::: "memory");
}
struct RmIn { __device__ __forceinline__ int operator()(int n) const { const int ct = n >> 8, f = n & 255; if (ct >= 8) return n;
        const int part = f >> 7, rem = f & 127, half = rem >> 6, i = rem & 63; return ct * 256 + half * 128 + part * 64 + i; } };
struct RmId { __device__ __forceinline__ int operator()(int n) const { return n; } };
struct RmGate { __device__ __forceinline__ int operator()(int n) const { return (n >> 7) * 256 + (n & 127); } };
struct RmUp { __device__ __forceinline__ int operator()(int n) const { return (n >> 7) * 256 + 128 + (n & 127); } };
constexpr int NCONV_IN = 7168, NCONV_OUT = 2048, NCONV_E = 16384, NCONV = NCONV_IN + NCONV_OUT + 3 * NCONV_E;
#ifndef SH3
#define SH3 21504
#endif
#ifndef A3
#define A3 30208
#endif
#ifndef A2
#define A2 4608
#endif
#ifndef A5
#define A5 6144
#endif
constexpr int CV_P3 = NCONV_IN, CV_P0 = CV_P3 + A3, CV_P2 = CV_P0 + A2, CV_P9 = CV_P2 + A5;
static_assert(CV_P9 >= NCONV_IN + NCONV_OUT + 2 * NCONV_E && CV_P9 <= NCONV, "gate/up copies must be complete before the gate/up phase");

__device__ __forceinline__ void conv_range(const Params& p, LAS unsigned char* lds, int first, int last, int worker, int nworkers, int wave, int lane) {
    LAS float* scr = (LAS float*)(lds + wave * 8448);
    bf16_t* WinT = (bf16_t*)(p.ws + WS_WIN); bf16_t* WoutT = (bf16_t*)(p.ws + WS_WOUT); unsigned char* WguT = p.ws + WS_WGU; unsigned char* WdT = p.ws + WS_WD;
    for (int it = first + worker; it < last; it += nworkers) {
        int r = it;
        if (r < NCONV_IN) { const int kb = r / 224, nb = r % 224;
            if (nb >= 128) conv_item8(p.w_in, 2 * DM, NIN, (unsigned char*)WinT, scr, kb, nb, lane, RmIn()); else conv_item(p.w_in, DM, NIN, WinT, scr, kb, nb, lane, RmIn()); continue; } r -= NCONV_IN;
        if (r < NCONV_OUT) { conv_item8(p.w_out, 2 * DM, DM, (unsigned char*)WoutT, scr, r / 64, r % 64, lane, RmId()); continue; } r -= NCONV_OUT;
        if (r < NCONV_E) { const int e = r >> 9, r2 = r & 511; conv_item8(p.w_gate + (size_t)e * DM * FF, DM, FF, WguT + (size_t)e * 1024 * DM, scr, r2 >> 4, r2 & 15, lane, RmGate()); continue; } r -= NCONV_E;
        if (r < NCONV_E) { const int e = r >> 9, r2 = r & 511; conv_item8(p.w_up + (size_t)e * DM * FF, DM, FF, WguT + (size_t)e * 1024 * DM, scr, r2 >> 4, r2 & 15, lane, RmUp()); continue; } r -= NCONV_E;
        { const int e = r >> 9, r2 = r & 511; conv_item8(p.w_down + (size_t)e * FF * DM, FF, DM, WdT + (size_t)e * DM * FF, scr, r2 >> 6, r2 & 63, lane, RmId()); }
    }
}
__device__ __forceinline__ void p0_mod_item(const Params& p, LAS unsigned char* lds, int ci, int tid, int wave, int lane) {
    LAS float* sl = (LAS float*)(lds + 69632);
    LAS float* red = (LAS float*)(lds + 69632 + 24576);
    for (int i = tid; i < 3 * 2048; i += 512) { const int r = i >> 11, k = i & 2047; const float v = (r < 2) ? p.c[r * 2048 + k] : p.c_ctx[k]; sl[i] = silu_f(v); }
    __syncthreads();
    const int rr = lane >> 4, cc = (lane & 15) * 4;
    f32x4 a0 = {0.f, 0.f, 0.f, 0.f}, a1 = a0, a2 = a0;
    const float* wp = p.w_mod + (size_t)(256 * wave + rr) * 12288 + 64 * ci + cc;
#pragma unroll 8
    for (int it = 0; it < 64; ++it) { const int k = 256 * wave + 4 * it + rr; const f32x4 wv = __builtin_nontemporal_load((const f32x4*)(wp + (size_t)(4 * it) * 12288));
        a0 += wv * sl[k]; a1 += wv * sl[2048 + k]; a2 += wv * sl[4096 + k]; }
#pragma unroll
    for (int e = 0; e < 4; ++e) { a0[e] = sum_g4(a0[e]); a1[e] = sum_g4(a1[e]); a2[e] = sum_g4(a2[e]); }
    if (lane < 16) {
#pragma unroll
        for (int e = 0; e < 4; ++e) { red[(wave * 3 + 0) * 64 + cc + e] = a0[e]; red[(wave * 3 + 1) * 64 + cc + e] = a1[e]; red[(wave * 3 + 2) * 64 + cc + e] = a2[e]; } }
    __syncthreads();
    if (tid < 192) { const int r = tid >> 6, col = tid & 63; float s = 0.f;
#pragma unroll
        for (int w = 0; w < 8; ++w) s += red[(w * 3 + r) * 64 + col];
        ((float*)(p.ws + WS_MOD))[r * 12288 + 64 * ci + col] = s + p.b_mod[64 * ci + col]; }
    asm volatile("s_waitcnt vmcnt(0)" ::: "memory");
    __syncthreads();
    if (tid == 0) { __builtin_amdgcn_fence(__ATOMIC_RELEASE, "agent"); asm volatile("s_waitcnt vmcnt(0)" ::: "memory");
        __hip_atomic_fetch_add((unsigned*)(p.ws + WS_CTL) + CW_MODRDY, 1u, __ATOMIC_RELAXED, __HIP_MEMORY_SCOPE_AGENT); }
}

__device__ __forceinline__ void p1_rows(const Params& p, int gw, int NGW, int lane) {
    const float* mod = (const float*)(p.ws + WS_MOD); bf16_t* HX = (bf16_t*)(p.ws + WS_HX); unsigned char* HX8 = p.ws + WS_X1;
    for (int row = gw; row < MALL; row += NGW) {
        const float* src = row < MTOK ? p.x + (size_t)row * DM : p.ctx + (size_t)(row - MTOK) * DM;
        const int mr = row < MTOK ? (row >> 12) : 2;
        const f32x4* xr = (const f32x4*)src + lane;
        f32x4 v[8]; float s = 0.f;
#pragma unroll
        for (int j = 0; j < 8; ++j) { v[j] = __builtin_nontemporal_load(xr + 64 * j); s += (v[j].x * v[j].x + v[j].y * v[j].y) + (v[j].z * v[j].z + v[j].w * v[j].w); }
        const float rstd = 1.0f / sqrtf(wave_sum(s) * (1.0f / DM) + NORM_EPS);
        u32x2* o8 = (u32x2*)(HX + (size_t)row * DM) + lane;
#pragma unroll
        for (int j = 0; j < 8; ++j) { const int cidx = 64 * j + lane;
            const f32x4 nw = ((const f32x4*)p.norm_mix_w)[cidx], sh = ((const f32x4*)(mod + mr * 12288))[cidx], sc = ((const f32x4*)(mod + mr * 12288 + 2048))[cidx];
            const f32x4 h = v[j] * rstd * nw * (sc + 1.0f) + sh;
            u32x2 w; w.x = cvt_pk_bf16(h.x, h.y); w.y = cvt_pk_bf16(h.z, h.w); o8[64 * j] = w;
            int q8 = __builtin_amdgcn_cvt_pk_fp8_f32(h.x, h.y, 0, false); q8 = __builtin_amdgcn_cvt_pk_fp8_f32(h.z, h.w, q8, true); *(int*)(HX8 + (size_t)row * (2 * DM) + 4 * cidx) = q8; }
    }
}

struct InProjSched {
    static constexpr bool GATHER = false;
    const char* hx; const char* win; int G, c;
    __device__ __forceinline__ bool next(int i, pg8::Unit& u) const {
        const int L = i * G + c; if (L >= 528) return false;
        int tt, ct, sw;
        if (L < 512) { const int x = L & 7, pos = L >> 3; tt = 4 * x + (pos & 3); const int jb = pos >> 2;
            if (jb < 12) { sw = 0; ct = jb < 8 ? jb : jb + 4; } else { sw = 1; ct = jb - 4; } }
        else { const int r = L - 512; tt = 32 + (r & 1); sw = 1; ct = 4 + (r >> 1); }
        const char* pa = hx + (size_t)tt * (256 * 2048 * 2); const char* pw = win + (size_t)ct * (256 * 2048 * 2);
        u.a = sw ? pw : pa; u.b = sw ? pa : pw; u.i0 = tt; u.i1 = ct; u.i2 = sw; u.i3 = 0; return true;
    }
};
struct InProjSched8 {
    static constexpr bool GATHER = false;
    const char* hx8; const char* win; int NW, w;
    __device__ __forceinline__ bool next(int i, pg8::Unit& u) const {
        if (w < 0) return false;
        const int L = i * NW + w; if (L >= 400) return false;
        int tt, ct, sw;
        if (L < 384) { tt = L & 31; const int jf = L >> 5; if (jf < 8) { sw = 0; ct = 16 + jf; } else { sw = 1; ct = 16 + jf; } }
        else { const int r = L - 384; tt = 32 + (r & 1); const int cj = r >> 1; if (cj < 4) { sw = 0; ct = 20 + cj; } else { sw = 1; ct = 20 + cj; } }
        const char* pa = hx8 + (size_t)tt * (256 * 2048 * 2); const char* pw = win + (size_t)ct * (256 * 2048 * 2);
        u.a = sw ? pw : pa; u.b = sw ? pa : pw; u.i0 = tt; u.i1 = ct; u.i2 = sw; u.i3 = 1; return true;
    }
};
struct EpiInProj {
    static constexpr bool PERM = true, CHAIN = false, AFTER_DRAIN = false;
    unsigned char* ws; const float *decf, *decb;
    __device__ __forceinline__ void store8(bf16_t* dst, const f32x4 v0, const f32x4 v1) const {
        u32x4 w; w.x = cvt_pk_bf16(v0[0], v0[1]); w.y = cvt_pk_bf16(v0[2], v0[3]); w.z = cvt_pk_bf16(v1[0], v1[1]); w.w = cvt_pk_bf16(v1[2], v1[3]); *(u32x4*)dst = w; }
    __device__ __forceinline__ void operator()(const f32x4 (&acc)[2][2][4][2], const pg8::Unit& u, int wr, int wc, int fr, int fq) const {
        asm volatile("" : "+v"(fr), "+v"(fq));
        const int tt = u.i0, ct = u.i1, sw = u.i2, grp = ct >> 2;
        const float ROPE_C = 0.20762050593046014f;
        if (!sw) {
            const int tok0 = 256 * tt + 64 * wr + fr;
            if (grp <= 1) {
                const int h = ct & 3, part = wc >> 1, ibase = 32 * (wc & 1) + 8 * fq;
                const float scale = grp == 1 ? 0.0625f : 1.0f; bf16_t* dst = (bf16_t*)(ws + (grp == 1 ? WS_K : WS_Q));
                const float lgf = log2_sigmoid(decf[h]), lgb = log2_sigmoid(decb[h]);
                const int bb = tt >> 4, uidx = (bb * 4 + h) * 16 + (tt & 15);
                bf16_t* QP = (bf16_t*)(ws + WS_QP) + (size_t)uidx * 256 * 768;
                bf16_t* kTf = (bf16_t*)(ws + WS_KTF) + (size_t)(bb * 4 + h) * 256 * LDT + 256 + 256 * (tt & 15); bf16_t* kTb = (bf16_t*)(ws + WS_KTB) + (size_t)(bb * 4 + h) * 256 * LDT + 256 + 256 * (tt & 15);
                float inv[2][4];
#pragma unroll
                for (int n = 0; n < 2; ++n)
#pragma unroll
                    for (int e = 0; e < 4; ++e) inv[n][e] = exp2f(-(float)(ibase + 4 * n + e) * ROPE_C);
#pragma unroll
                for (int ai = 0; ai < 2; ++ai)
#pragma unroll
                    for (int m = 0; m < 4; ++m) { const int pl = 128 * ai + 64 * wr + 16 * m + fr, tok = 256 * tt + pl, ntok = tok & 4095; const float pos = (float)(part ? (ntok & 63) : (ntok >> 6));
                        f32x4 o1[2], o2[2];
#pragma unroll
                        for (int n = 0; n < 2; ++n)
#pragma unroll
                            for (int e = 0; e < 4; ++e) { float sn, cs; sincos_ang(pos * inv[n][e], sn, cs); const float x1 = acc[ai][0][m][n][e], x2 = acc[ai][1][m][n][e];
                                o1[n][e] = (x1 * cs - x2 * sn) * scale; o2[n][e] = (x1 * sn + x2 * cs) * scale; }
                        bf16_t* rowp = dst + (size_t)tok * 1024 + h * 256 + part * 128 + ibase;
                        store8(rowp, o1[0], o1[1]); store8(rowp + 64, o2[0], o2[1]);
                        if (grp == 0) {
                            const float rf = exp2f(lgf * (float)(pl + 1)), rb = exp2f(lgb * (float)(256 - pl));
                            bf16_t* qrow = QP + (size_t)pl * 768 + part * 128 + ibase;
                            store8(qrow, o1[0] * rf, o1[1] * rf); store8(qrow + 64, o2[0] * rf, o2[1] * rf);
                            store8(qrow + 256, o1[0] * rb, o1[1] * rb); store8(qrow + 256 + 64, o2[0] * rb, o2[1] * rb);
                        } else {
                            const float dfr = exp2f(lgf * (float)(255 - pl)), dbr = exp2f(lgb * (float)pl);
#pragma unroll
                            for (int n = 0; n < 2; ++n)
#pragma unroll
                                for (int e = 0; e < 4; ++e) { const int f1 = part * 128 + ibase + 4 * n + e;
                                    const unsigned w1 = cvt_pk_bf16(o1[n][e] * dfr, o1[n][e] * dbr), w2 = cvt_pk_bf16(o2[n][e] * dfr, o2[n][e] * dbr);
                                    kTf[(size_t)f1 * LDT + pl] = (bf16_t)(w1 & 0xffffu); kTb[(size_t)f1 * LDT + pl] = (bf16_t)(w1 >> 16);
                                    kTf[(size_t)(f1 + 64) * LDT + pl] = (bf16_t)(w2 & 0xffffu); kTb[(size_t)(f1 + 64) * LDT + pl] = (bf16_t)(w2 >> 16); }
                        }
                        __builtin_amdgcn_sched_barrier(0); }
            } else {
                bf16_t* dst = (bf16_t*)(ws + (grp == 3 ? WS_G : (grp == 4 ? WS_NQ : WS_NK))); const int cb = (ct & 3) * 256 + 32 * wc + 8 * fq;
                const float s8 = (grp == 4 ? 0.08838834764831845f : 1.0f) * (u.i3 ? 1.0f / W8_SCALE : 1.0f);
#pragma unroll
                for (int ai = 0; ai < 2; ++ai)
#pragma unroll
                    for (int m = 0; m < 4; ++m) { const int tok = tok0 + 128 * ai + 16 * m;
#pragma unroll
                        for (int bj = 0; bj < 2; ++bj) { f32x4 v0 = acc[ai][bj][m][0], v1 = acc[ai][bj][m][1];
                            if (grp == 3) {
#pragma unroll
                                for (int e = 0; e < 4; ++e) { v0[e] = silu_f(v0[e]); v1[e] = silu_f(v1[e]); } }
                            else { v0 = v0 * s8; v1 = v1 * s8; }
                            store8(dst + (size_t)tok * 1024 + cb + 128 * bj, v0, v1); } __builtin_amdgcn_sched_barrier(0); }
            }
        } else {
            const bool isctx = tt >= 32; const int b = isctx ? tt - 32 : (tt >> 4);
            const int tcol0 = 32 * wc + 8 * fq;
            const int colbase = isctx ? 0 : 256 + 256 * (tt & 15);
            if (grp == 1) {
                bf16_t* kTf = (bf16_t*)(ws + WS_KTF); bf16_t* kTb = (bf16_t*)(ws + WS_KTB);
                const int h = ct & 3, part = wr; const float lgf = log2_sigmoid(decf[h]), lgb = log2_sigmoid(decb[h]);
                float inv[4];
#pragma unroll
                for (int m = 0; m < 4; ++m) inv[m] = exp2f(-(float)(16 * m + fr) * ROPE_C);
#pragma unroll
                for (int bj = 0; bj < 2; ++bj) {
                    float df[2][4], db[2][4], pos[2][4];
#pragma unroll
                    for (int n = 0; n < 2; ++n)
#pragma unroll
                        for (int e = 0; e < 4; ++e) { const int tcol = 128 * bj + tcol0 + 4 * n + e; df[n][e] = exp2f(lgf * (float)(255 - tcol)) * 0.0625f; db[n][e] = exp2f(lgb * (float)tcol) * 0.0625f;
                            pos[n][e] = (float)(part ? (tcol & 63) : (4 * (tt & 15) + (tcol >> 6))); }
#pragma unroll
                    for (int m = 0; m < 4; ++m) { const int i = 16 * m + fr, f1 = part * 128 + i;
                        f32x4 o1[2], o2[2];
#pragma unroll
                        for (int n = 0; n < 2; ++n)
#pragma unroll
                            for (int e = 0; e < 4; ++e) { const float x1 = acc[0][bj][m][n][e], x2 = acc[1][bj][m][n][e]; float y1 = x1, y2 = x2;
                                if (!isctx) { float sn, cs; sincos_ang(pos[n][e] * inv[m], sn, cs); y1 = x1 * cs - x2 * sn; y2 = x1 * sn + x2 * cs; }
                                o1[n][e] = y1; o2[n][e] = y2; }
                        const size_t r1 = ((size_t)(b * 4 + h) * 256 + f1) * LDT + colbase + 128 * bj + tcol0, r2 = r1 + (size_t)64 * LDT;
                        { f32x4 t0, t1; for (int e = 0; e < 4; ++e) { t0[e] = o1[0][e] * df[0][e]; t1[e] = o1[1][e] * df[1][e]; } store8(kTf + r1, t0, t1); }
                        __builtin_amdgcn_sched_barrier(0);
                        { f32x4 t0, t1; for (int e = 0; e < 4; ++e) { t0[e] = o2[0][e] * df[0][e]; t1[e] = o2[1][e] * df[1][e]; } store8(kTf + r2, t0, t1); }
                        __builtin_amdgcn_sched_barrier(0);
                        { f32x4 t0, t1; for (int e = 0; e < 4; ++e) { t0[e] = o1[0][e] * db[0][e]; t1[e] = o1[1][e] * db[1][e]; } store8(kTb + r1, t0, t1); }
                        __builtin_amdgcn_sched_barrier(0);
                        { f32x4 t0, t1; for (int e = 0; e < 4; ++e) { t0[e] = o2[0][e] * db[0][e]; t1[e] = o2[1][e] * db[1][e]; } store8(kTb + r2, t0, t1); }
                        __builtin_amdgcn_sched_barrier(0); }
                }
            } else {
#pragma unroll
                for (int ai = 0; ai < 2; ++ai)
#pragma unroll
                    for (int m = 0; m < 4; ++m) { const int pr = 128 * ai + 64 * wr + 16 * m + fr;
                        bf16_t* rowp = (bf16_t*)(ws + WS_NVT) + ((size_t)(b * 8 + 2 * (ct & 3) + ai) * 128 + (pr & 127)) * LDT + colbase;
                        if (grp == 2) rowp = isctx ? (bf16_t*)(ws + WS_SVC) + ((size_t)(b * 4 + (ct & 3)) * 256 + pr) * 768 + 512 : (bf16_t*)(ws + WS_SV) + ((size_t)((b * 4 + (ct & 3)) * 16 + (tt & 15)) * 256 + pr) * 768 + 512;
#pragma unroll
                        for (int bj = 0; bj < 2; ++bj) { const float s8 = u.i3 ? 1.0f / W8_SCALE : 1.0f; store8(rowp + 128 * bj + tcol0, acc[ai][bj][m][0] * s8, acc[ai][bj][m][1] * s8); } __builtin_amdgcn_sched_barrier(0); }
            }
        }
    }
};

struct ChainSched {
    static constexpr bool GATHER = false;
    const char* sv; const char* svc; const char* kT; int dir;
    __device__ __forceinline__ bool next(int i, pg8::Unit& u) const {
        if (i >= 16) return false;
        const int c = dir == 0 ? i - 1 : 16 - i;
        u.a = (i == 0) ? svc : sv + (size_t)c * (256 * 768 * 2); u.b = kT + (size_t)((i == 0) ? 0 : 256 + 256 * c) * 2;
        u.i0 = dir == 0 ? i : 15 - i; u.i1 = 0; u.i2 = 0; u.i3 = 0; return true;
    }
};
struct EpiChain {
    static constexpr bool PERM = true, CHAIN = true, AFTER_DRAIN = false;
    bf16_t* SVbh; int dir; float cdec;
    __device__ __forceinline__ float chain_scale(const pg8::Unit&) const { return cdec; }
    __device__ __forceinline__ void operator()(const f32x4 (&acc)[2][2][4][2], const pg8::Unit& u, int wr, int wc, int fr, int fq) const {
        asm volatile("" : "+v"(fr), "+v"(fq));
        bf16_t* base = SVbh + (size_t)u.i0 * (256 * 768) + dir * 256;
#pragma unroll
        for (int ai = 0; ai < 2; ++ai)
#pragma unroll
            for (int m = 0; m < 4; ++m) { bf16_t* rowp = base + (size_t)(128 * ai + 64 * wr + 16 * m + fr) * 768 + 32 * wc + 8 * fq;
#pragma unroll
                for (int bj = 0; bj < 2; ++bj) { const f32x4 v0 = acc[ai][bj][m][0], v1 = acc[ai][bj][m][1];
                    u32x4 w; w.x = cvt_pk_bf16(v0[0], v0[1]); w.y = cvt_pk_bf16(v0[2], v0[3]); w.z = cvt_pk_bf16(v1[0], v1[1]); w.w = cvt_pk_bf16(v1[2], v1[3]); *(u32x4*)(rowp + 128 * bj) = w; } }
    }
};
struct ScoreSched {
    static constexpr bool GATHER = false;
    const char* q; const char* k; int unit;
    __device__ __forceinline__ bool next(int i, pg8::Unit& u) const {
        if (i > 0 || unit < 0) return false;
        const int c = unit & 15, h = (unit >> 4) & 3, b = unit >> 6; const size_t off = ((size_t)(b * 4096 + 256 * c) * 1024 + h * 256) * 2;
        u.a = q + off; u.b = k + off; u.i0 = unit; u.i1 = h; u.i2 = 0; u.i3 = 0; return true;
    }
};
struct EpiScore {
    static constexpr bool PERM = true, CHAIN = false, AFTER_DRAIN = false;
    bf16_t* QP; const float *decf, *decb;
    __device__ __forceinline__ void operator()(const f32x4 (&acc)[2][2][4][2], const pg8::Unit& u, int wr, int wc, int fr, int fq) const {
        asm volatile("" : "+v"(fr), "+v"(fq));
        const float lgf = log2_sigmoid(decf[u.i1]), lgb = log2_sigmoid(decb[u.i1]);
        bf16_t* base = QP + (size_t)u.i0 * (256 * 768) + 512;
#pragma unroll
        for (int ai = 0; ai < 2; ++ai)
#pragma unroll
            for (int m = 0; m < 4; ++m) { const int i = 128 * ai + 64 * wr + 16 * m + fr;
#pragma unroll
                for (int bj = 0; bj < 2; ++bj) { const int j0 = 128 * bj + 32 * wc + 8 * fq; f32x4 v[2];
#pragma unroll
                    for (int n = 0; n < 2; ++n)
#pragma unroll
                        for (int e = 0; e < 4; ++e) { const int d = i - (j0 + 4 * n + e); const float D = d > 0 ? exp2f(lgf * (float)d) : (d < 0 ? exp2f(lgb * (float)(-d)) : 2.0f); v[n][e] = acc[ai][bj][m][n][e] * D; }
                    u32x4 w; w.x = cvt_pk_bf16(v[0][0], v[0][1]); w.y = cvt_pk_bf16(v[0][2], v[0][3]); w.z = cvt_pk_bf16(v[1][0], v[1][1]); w.w = cvt_pk_bf16(v[1][2], v[1][3]);
                    *(u32x4*)(base + (size_t)i * 768 + j0) = w; }
                __builtin_amdgcn_sched_barrier(0); }
    }
};
struct RetOutSched {
    static constexpr bool GATHER = false;
    const char* qp; const char* sv; int unit;
    __device__ __forceinline__ bool next(int i, pg8::Unit& u) const {
        if (i > 0 || unit < 0) return false;
        u.a = qp + (size_t)unit * (256 * 768 * 2); u.b = sv + (size_t)unit * (256 * 768 * 2); u.i0 = unit; u.i1 = 0; u.i2 = 0; u.i3 = 0; return true;
    }
};
struct EpiRetOut {
    static constexpr bool PERM = true, CHAIN = false, AFTER_DRAIN = true;
    const bf16_t* G; const float* gnw; bf16_t* MIX;
    __device__ __forceinline__ void operator()(const f32x4 (&)[2][2][4][2], const pg8::Unit&, int, int, int, int) const {}
    __device__ __forceinline__ void fused(const f32x4 (&acc)[2][2][4][2], const pg8::Unit& u, int wr, int wc, int fr, int fq, LAS unsigned char* lds) const {
        asm volatile("" : "+v"(fr), "+v"(fq));
        const int unit = u.i0, c = unit & 15, h = (unit >> 4) & 3, b = unit >> 6;
        LAS f32x2* Pst = (LAS f32x2*)lds;
#pragma unroll
        for (int ai = 0; ai < 2; ++ai)
#pragma unroll
            for (int m = 0; m < 4; ++m) { float s = 0.f, q = 0.f;
#pragma unroll
                for (int bj = 0; bj < 2; ++bj)
#pragma unroll
                    for (int n = 0; n < 2; ++n) { const f32x4 x = acc[ai][bj][m][n]; s += (x[0] + x[1]) + (x[2] + x[3]); q += (x[0] * x[0] + x[1] * x[1]) + (x[2] * x[2] + x[3] * x[3]); }
                s = sum_g4(s); q = sum_g4(q);
                if (fq == 0) Pst[(128 * ai + 64 * wr + 16 * m + fr) * 4 + wc] = (f32x2){s, q}; }
        asm volatile("s_waitcnt lgkmcnt(0)" ::: "memory"); __builtin_amdgcn_s_barrier(); asm volatile("" ::: "memory");
        f32x4 gw0[2], gw1[2];
#pragma unroll
        for (int bj = 0; bj < 2; ++bj) { const int v0 = h * 256 + 128 * bj + 32 * wc + 8 * fq; gw0[bj] = *(const f32x4*)(gnw + v0); gw1[bj] = *(const f32x4*)(gnw + v0 + 4); }
#pragma unroll
        for (int ai = 0; ai < 2; ++ai) {
            u32x4 gg[4][2];
#pragma unroll
            for (int m = 0; m < 4; ++m) { const size_t tok = (size_t)b * 4096 + 256 * c + 128 * ai + 64 * wr + 16 * m + fr;
#pragma unroll
                for (int bj = 0; bj < 2; ++bj) gg[m][bj] = *(const u32x4*)(G + tok * 1024 + h * 256 + 128 * bj + 32 * wc + 8 * fq); }
#pragma unroll
            for (int m = 0; m < 4; ++m) { const int r = 128 * ai + 64 * wr + 16 * m + fr;
                const f32x2 p0 = Pst[r * 4 + 0], p1 = Pst[r * 4 + 1], p2 = Pst[r * 4 + 2], p3 = Pst[r * 4 + 3];
                const float mu = ((p0.x + p1.x) + (p2.x + p3.x)) * (1.0f / 256.0f); const float ex2 = ((p0.y + p1.y) + (p2.y + p3.y)) * (1.0f / 256.0f);
                const float rstd = 1.0f / sqrtf(fmaxf(ex2 - mu * mu, 0.f) + NORM_EPS);
                const size_t tok = (size_t)b * 4096 + 256 * c + r;
#pragma unroll
                for (int bj = 0; bj < 2; ++bj) { const int v0 = h * 256 + 128 * bj + 32 * wc + 8 * fq; const u32x4 g4 = gg[m][bj];
                    const f32x4 y0 = (acc[ai][bj][m][0] - mu) * rstd * gw0[bj], y1 = (acc[ai][bj][m][1] - mu) * rstd * gw1[bj];
                    float h8[8] = {y0[0] * bflo(g4.x) * MIX8_SCALE, y0[1] * bfhi(g4.x) * MIX8_SCALE, y0[2] * bflo(g4.y) * MIX8_SCALE, y0[3] * bfhi(g4.y) * MIX8_SCALE,
                                   y1[0] * bflo(g4.z) * MIX8_SCALE, y1[1] * bfhi(g4.z) * MIX8_SCALE, y1[2] * bflo(g4.w) * MIX8_SCALE, y1[3] * bfhi(g4.w) * MIX8_SCALE};
                    *(u32x2*)((unsigned char*)MIX + tok * 4096 + v0) = cvt8_fp8(h8); } }
        }
    }
};

__device__ __forceinline__ bf16x8 pack8(const f32x4 a, const f32x4 b) {
    u32x4 w; w.x = cvt_pk_bf16(a[0], a[1]); w.y = cvt_pk_bf16(a[2], a[3]); w.z = cvt_pk_bf16(b[0], b[1]); w.w = cvt_pk_bf16(b[2], b[3]); return __builtin_bit_cast(bf16x8, w); }
__device__ __forceinline__ bf16x8 ld44(const bf16_t* p0) { const s16x4 lo = *(const s16x4*)p0, hi = *(const s16x4*)(p0 + 16); bf16x8 r; r[0] = lo[0]; r[1] = lo[1]; r[2] = lo[2]; r[3] = lo[3]; r[4] = hi[0]; r[5] = hi[1]; r[6] = hi[2]; r[7] = hi[3]; return r; }

__device__ __forceinline__ void na_item(const Params& p, int it, int lane) {
    asm volatile("" : "+v"(lane));
    const bf16_t* NQ = (const bf16_t*)(p.ws + WS_NQ); const bf16_t* NK = (const bf16_t*)(p.ws + WS_NK); const bf16_t* NVT = (const bf16_t*)(p.ws + WS_NVT); bf16_t* MIX = (bf16_t*)(p.ws + WS_MIX);
    const int qb = it & 3, r = (it >> 2) & 63, nh = (it >> 8) & 7, b = it >> 11;
    const int l15 = lane & 15, g = lane >> 4;
    const int rs = min(max(r - 4, 0), 56), c0 = min(max(16 * qb - 8, 0), 32);
    const int qc = 16 * qb + l15; const size_t tq = (size_t)b * 4096 + r * 64 + qc;
    bf16x8 bq[4];
#pragma unroll
    for (int ks = 0; ks < 4; ++ks) bq[ks] = *(const bf16x8*)(NQ + tq * 1024 + nh * 128 + 32 * ks + 8 * g);
    f32x4 s[32];
#pragma unroll
    for (int f = 0; f < 32; ++f) {
        size_t kt;
        if (f < 16) kt = (size_t)b * 4096 + (rs + (f >> 1)) * 64 + c0 + 16 * (f & 1) + l15; else kt = (size_t)MTOK + b * 256 + 16 * (f - 16) + l15;
        const bf16_t* kp = NK + kt * 1024 + nh * 128 + 8 * g;
        f32x4 a = {0.f, 0.f, 0.f, 0.f};
#pragma unroll
        for (int ks = 0; ks < 4; ++ks) a = __builtin_amdgcn_mfma_f32_16x16x32_bf16(*(const bf16x8*)(kp + 32 * ks), bq[ks], a, 0, 0, 0);
        s[f] = a;
    }
    const int cs = min(max(qc - 8, 0), 48);
    const float* rp = p.na_rpb + nh * 15 * 31;
    float mx = -1e30f;
#pragma unroll
    for (int f = 0; f < 16; ++f) { const int kr = f >> 1; const float* rrow = rp + (rs + kr - r + 7) * 31;
#pragma unroll
        for (int j = 0; j < 4; ++j) { const int kc = c0 + 16 * (f & 1) + 4 * g + j; const bool valid = (kc >= cs) && (kc < cs + 16);
            float v = -1e30f; if (valid) v = s[f][j] + rrow[kc - qc + 15]; s[f][j] = v; mx = fmaxf(mx, v); } }
#pragma unroll
    for (int f = 16; f < 32; ++f)
#pragma unroll
        for (int j = 0; j < 4; ++j) mx = fmaxf(mx, s[f][j]);
    mx = max_g4(mx);
    float l = 0.f;
#pragma unroll
    for (int f = 0; f < 32; ++f)
#pragma unroll
        for (int j = 0; j < 4; ++j) { const float v = s[f][j]; const float e = (v <= -1e29f) ? 0.f : exp2f((v - mx) * LOG2E); s[f][j] = e; l += e; }
    l = sum_g4(l);
    f32x4 o[8];
#pragma unroll
    for (int df = 0; df < 8; ++df) o[df] = (f32x4){0.f, 0.f, 0.f, 0.f};
#pragma unroll
    for (int t = 0; t < 16; ++t) {
        const bf16x8 pb = pack8(s[2 * t], s[2 * t + 1]);
        const int col = (t < 8) ? 256 + (rs + t) * 64 + c0 + 4 * g : 32 * (t - 8) + 4 * g;
#pragma unroll
        for (int df = 0; df < 8; ++df) { const bf16_t* vp = NVT + ((size_t)(b * 8 + nh) * 128 + 16 * df + l15) * LDT + col;
            o[df] = __builtin_amdgcn_mfma_f32_16x16x32_bf16(ld44(vp), pb, o[df], 0, 0, 0); }
    }
    const float inv = 1.0f / l;
#pragma unroll
    for (int df = 0; df < 8; ++df) { u32x2 w; w.x = cvt_pk_bf16(o[df][0] * inv, o[df][1] * inv); w.y = cvt_pk_bf16(o[df][2] * inv, o[df][3] * inv);
        *(u32x2*)(MIX + tq * 2048 + 1024 + nh * 128 + 16 * df + 4 * g) = w; }
}


__device__ __forceinline__ void na_wg_item(const Params& p, LAS unsigned char* lds, int item, int wave, int lane) {
    asm volatile("" : "+v"(lane));
    const bf16_t* NQ = (const bf16_t*)(p.ws + WS_NQ); const bf16_t* NK = (const bf16_t*)(p.ws + WS_NK); const bf16_t* NVT = (const bf16_t*)(p.ws + WS_NVT); bf16_t* MIX = (bf16_t*)(p.ws + WS_MIX);
    const int r = item & 63, nh = (item >> 6) & 7, b = item >> 9;
    const int tid = wave * 64 + lane, l15 = lane & 15, g = lane >> 4, qb = wave & 3, half = wave >> 2;
    const int rs = min(max(r - 4, 0), 56), c0 = min(max(16 * qb - 8, 0), 32);
    const int qc = 16 * qb + l15; const size_t tq = (size_t)b * 4096 + r * 64 + qc;
    LAS float* mxs = (LAS float*)(lds + 148480);
    LAS float* sms = mxs + 128;
    LAS float* rpbs = (LAS float*)(lds + 150528);
    LAS unsigned char* xo = lds + 98304;
    bf16x8 bq[4];
#pragma unroll
    for (int ks = 0; ks < 4; ++ks) bq[ks] = *(const bf16x8*)(NQ + tq * 1024 + nh * 128 + 32 * ks + 8 * g);
    if (tid < 465) rpbs[tid] = p.na_rpb[nh * 465 + tid];
    asm volatile("s_waitcnt vmcnt(0)" ::: "memory");
    const bf16_t* nvrow = NVT + (size_t)(b * 8 + nh) * 128 * LDT;
#define NA_DMAK(s, buf) do { _Pragma("unroll") for (int i = 0; i < 6; ++i) { const int q = wave + 8 * i, row = 4 * q + (lane >> 4), c = (lane & 15) ^ (row & 15); \
        const size_t trow = (i < 4) ? (size_t)b * 4096 + (rs + 2 * (s) + (row >> 6)) * 64 + (row & 63) : (size_t)MTOK + b * 256 + 64 * (s) + (row - 128); \
        __builtin_amdgcn_global_load_lds((const unsigned*)(NK + trow * 1024 + nh * 128 + 8 * c), (LAS unsigned*)((buf) + q * 1024), 16, 0, 0); } } while (0)
#define NA_DMAV(s, buf) do { _Pragma("unroll") for (int i = 0; i < 6; ++i) { \
        if (i < 4) { const int q = wave + 8 * i, d = 4 * q + (lane >> 4), c = (lane & 15) ^ (d & 15); \
            __builtin_amdgcn_global_load_lds((const unsigned*)(nvrow + (size_t)d * LDT + 256 + (rs + 2 * (s)) * 64 + 8 * c), (LAS unsigned*)((buf) + q * 1024), 16, 0, 0); } \
        else { const int q2 = wave + 8 * (i - 4), d = 8 * q2 + (lane >> 3), c = (lane & 7) ^ (d & 7); \
            __builtin_amdgcn_global_load_lds((const unsigned*)(nvrow + (size_t)d * LDT + 64 * (s) + 8 * c), (LAS unsigned*)((buf) + 32768 + q2 * 1024), 16, 0, 0); } } } while (0)
#define NA_BUF(gst) (lds + ((gst) % 3) * 49152)
#define NA_SYNC(n) do { asm volatile("s_waitcnt vmcnt(" #n ") lgkmcnt(0)" ::: "memory"); __builtin_amdgcn_s_barrier(); asm volatile("" ::: "memory"); } while (0)
    f32x4 sf[16];
    NA_DMAK(0, NA_BUF(0)); NA_DMAK(1, NA_BUF(1)); NA_SYNC(6);
#pragma unroll
    for (int s = 0; s < 4; ++s) {
        LAS unsigned char* cur = NA_BUF(s);
        if (s == 0) NA_DMAK(2, NA_BUF(2)); else if (s == 1) NA_DMAK(3, NA_BUF(3)); else if (s == 2) NA_DMAV(0, NA_BUF(4)); else NA_DMAV(1, NA_BUF(5));
#pragma unroll
        for (int fi = 0; fi < 4; ++fi) { const int row = half ? 128 + 16 * fi + l15 : (fi >> 1) * 64 + c0 + 16 * (fi & 1) + l15;
            f32x4 a = {0.f, 0.f, 0.f, 0.f};
#pragma unroll
            for (int ks = 0; ks < 4; ++ks) a = __builtin_amdgcn_mfma_f32_16x16x32_bf16(*(const LAS bf16x8*)(cur + row * 256 + (((4 * ks + g) ^ (row & 15)) << 4)), bq[ks], a, 0, 0, 0);
            sf[4 * s + fi] = a; }
        NA_SYNC(6);
    }
    float mx = -1e30f;
    if (!half) {
        const int cs = min(max(qc - 8, 0), 48);
#pragma unroll
        for (int f = 0; f < 16; ++f) { const int kr = f >> 1; const LAS float* rrow = rpbs + (rs + kr - r + 7) * 31 - qc + 15;
#pragma unroll
            for (int j = 0; j < 4; ++j) { const int kc = c0 + 16 * (f & 1) + 4 * g + j; const bool valid = (kc >= cs) && (kc < cs + 16);
                float v = -1e30f; if (valid) v = sf[f][j] + rrow[kc]; sf[f][j] = v; mx = fmaxf(mx, v); } }
    } else {
#pragma unroll
        for (int f = 0; f < 16; ++f)
#pragma unroll
            for (int j = 0; j < 4; ++j) mx = fmaxf(mx, sf[f][j]);
    }
    mx = max_g4(mx);
    if (g == 0) mxs[half * 64 + qc] = mx;
    NA_SYNC(6);
    mx = fmaxf(mxs[qc], mxs[64 + qc]) * LOG2E;
    float l = 0.f;
#pragma unroll
    for (int f = 0; f < 16; ++f)
#pragma unroll
        for (int j = 0; j < 4; ++j) { const float v = sf[f][j]; const float e = (v <= -1e29f) ? 0.f : __builtin_amdgcn_exp2f(v * LOG2E - mx); sf[f][j] = e; l += e; }
    l = sum_g4(l);
    if (g == 0) sms[half * 64 + qc] = l;
    bf16x8 pb[8];
#pragma unroll
    for (int t = 0; t < 8; ++t) pb[t] = pack8(sf[2 * t], sf[2 * t + 1]);
    f32x4 o[8];
#pragma unroll
    for (int df = 0; df < 8; ++df) o[df] = (f32x4){0.f, 0.f, 0.f, 0.f};
    const int vbase = half ? 32768 : 0, vstride = half ? 128 : 256, vsw = l15 & (half ? 7 : 15);
#pragma unroll
    for (int s = 0; s < 4; ++s) {
        LAS unsigned char* cur = NA_BUF(s + 4);
        if (s == 0) NA_DMAV(2, NA_BUF(6)); else if (s == 1) NA_DMAV(3, NA_BUF(7));
#pragma unroll
        for (int k2 = 0; k2 < 2; ++k2) { const int ch0 = (half ? 4 * k2 : 8 * k2 + (c0 >> 3)) + (g >> 1);
#pragma unroll
            for (int df = 0; df < 8; ++df) { const LAS unsigned char* rowp = cur + vbase + (16 * df + l15) * vstride + 8 * (g & 1);
                const s16x4 lo = *(const LAS s16x4*)(rowp + ((ch0 ^ vsw) << 4)), hi = *(const LAS s16x4*)(rowp + (((ch0 + 2) ^ vsw) << 4));
                bf16x8 a; a[0] = lo[0]; a[1] = lo[1]; a[2] = lo[2]; a[3] = lo[3]; a[4] = hi[0]; a[5] = hi[1]; a[6] = hi[2]; a[7] = hi[3];
                o[df] = __builtin_amdgcn_mfma_f32_16x16x32_bf16(a, pb[2 * s + k2], o[df], 0, 0, 0); } }
        if (s == 3 && half) {
#pragma unroll
            for (int df = 0; df < 8; ++df) *(LAS f32x4*)(xo + ((qb * 8 + df) * 64 + lane) * 16) = o[df]; }
        if (s < 2) NA_SYNC(6); else NA_SYNC(0);
    }
    if (!half) {
        const float inv = 1.0f / (sms[qc] + sms[64 + qc]);
#pragma unroll
        for (int df = 0; df < 8; ++df) { const f32x4 oc = *(const LAS f32x4*)(xo + ((qb * 8 + df) * 64 + lane) * 16); const f32x4 t = (o[df] + oc) * (inv * MIX8_SCALE);
            int q8 = __builtin_amdgcn_cvt_pk_fp8_f32(t[0], t[1], 0, false); q8 = __builtin_amdgcn_cvt_pk_fp8_f32(t[2], t[3], q8, true);
            *(int*)((unsigned char*)MIX + tq * 4096 + 1024 + nh * 128 + 16 * df + 4 * g) = q8; }
    }
    NA_SYNC(0);
#undef NA_BUF
#undef NA_DMAK
#undef NA_DMAV
#undef NA_SYNC
}

struct OutProjSched {
    static constexpr bool GATHER = false;
    const char* mix; const char* wout; int G, c;
    __device__ __forceinline__ bool next(int i, pg8::Unit& u) const {
        const int L = i * G + c; if (L >= 256) return false;
        const int x = L & 7, pos = L >> 3, tt = 4 * x + (pos & 3), nt = pos >> 2;
        u.a = mix + (size_t)tt * (256 * 2048 * 2); u.b = wout + (size_t)nt * (256 * 2048 * 2); u.i0 = tt; u.i1 = nt; u.i2 = 0; u.i3 = 0; return true;
    }
};
struct EpiOutProj {
    static constexpr bool PERM = true, CHAIN = false, AFTER_DRAIN = false;
    const float* x; const float* mod; bf16_t* x1;
    __device__ __forceinline__ void operator()(const f32x4 (&acc)[2][2][4][2], const pg8::Unit& u, int wr, int wc, int fr, int fq) const {
        asm volatile("" : "+v"(fr), "+v"(fq));
        const int tt = u.i0, b = tt >> 4; const int col0 = 256 * u.i1 + 32 * wc + 8 * fq;
        const float* ga = mod + b * 12288 + 2 * 2048;
        f32x4 gv[2][2];
#pragma unroll
        for (int bj = 0; bj < 2; ++bj) { gv[bj][0] = *(const f32x4*)(ga + col0 + 128 * bj) * (1.0f / (W8_SCALE * MIX8_SCALE)); gv[bj][1] = *(const f32x4*)(ga + col0 + 128 * bj + 4) * (1.0f / (W8_SCALE * MIX8_SCALE)); }
#pragma unroll
        for (int am = 0; am < 4; ++am) { const int ai = am >> 1, mb = 2 * (am & 1);
            f32x4 xv[2][2][2];
#pragma unroll
            for (int m = 0; m < 2; ++m) { const size_t off = (size_t)(256 * tt + 128 * ai + 64 * wr + 16 * (mb + m) + fr) * DM + col0;
#pragma unroll
                for (int bj = 0; bj < 2; ++bj) { xv[m][bj][0] = __builtin_nontemporal_load((const f32x4*)(x + off + 128 * bj)); xv[m][bj][1] = __builtin_nontemporal_load((const f32x4*)(x + off + 128 * bj + 4)); } }
#pragma unroll
            for (int m = 0; m < 2; ++m) { const size_t off = (size_t)(256 * tt + 128 * ai + 64 * wr + 16 * (mb + m) + fr) * DM + col0;
#pragma unroll
                for (int bj = 0; bj < 2; ++bj) { const f32x4 r0 = xv[m][bj][0] + gv[bj][0] * acc[ai][bj][mb + m][0], r1 = xv[m][bj][1] + gv[bj][1] * acc[ai][bj][mb + m][1];
                    u32x4 w; w.x = cvt_pk_bf16(r0[0], r0[1]); w.y = cvt_pk_bf16(r0[2], r0[3]); w.z = cvt_pk_bf16(r1[0], r1[1]); w.w = cvt_pk_bf16(r1[2], r1[3]);
                    *(u32x4*)(x1 + off + 128 * bj) = w; } }
        }
    }
};

constexpr int P7_LD = 2050;
__device__ __forceinline__ void p7_item(const Params& p, LAS unsigned char* lds, int item, int slot, int tid, int wave, int lane) {
    const float* mod = (const float*)(p.ws + WS_MOD); const bf16_t* X1 = (const bf16_t*)(p.ws + WS_X1); unsigned char* HF = p.ws + WS_HF;
    LAS float* hfs = (LAS float*)lds;
    LAS float* red = (LAS float*)(lds + 131584);
    const int row0 = item * 16;
    {
        u32x4 raw[2][4];
#pragma unroll
        for (int rr = 0; rr < 2; ++rr)
#pragma unroll
            for (int j = 0; j < 4; ++j) raw[rr][j] = ((const u32x4*)(X1 + (size_t)(row0 + 2 * wave + rr) * DM))[64 * j + lane];
#pragma unroll
        for (int rr = 0; rr < 2; ++rr) {
            const int li = 2 * wave + rr, row = row0 + li, b = row >> 12;
            float v[4][8]; float s = 0.f;
#pragma unroll
            for (int j = 0; j < 4; ++j) { const u32x4 w = raw[rr][j];
                v[j][0] = bflo(w.x); v[j][1] = bfhi(w.x); v[j][2] = bflo(w.y); v[j][3] = bfhi(w.y); v[j][4] = bflo(w.z); v[j][5] = bfhi(w.z); v[j][6] = bflo(w.w); v[j][7] = bfhi(w.w);
#pragma unroll
                for (int e = 0; e < 8; ++e) s += v[j][e] * v[j][e]; }
            const float rstd = 1.0f / sqrtf(wave_sum(s) * (1.0f / DM) + NORM_EPS);
            u32x2* o8 = (u32x2*)(HF + (size_t)row * DM) + lane;
#pragma unroll
            for (int j = 0; j < 4; ++j) { const int c8 = 2 * (64 * j + lane);
                float h[8];
#pragma unroll
                for (int q = 0; q < 2; ++q) { const f32x4 nw = ((const f32x4*)p.norm_ffn_w)[c8 + q], sh = ((const f32x4*)(mod + b * 12288 + 3 * 2048))[c8 + q], sc = ((const f32x4*)(mod + b * 12288 + 4 * 2048))[c8 + q];
#pragma unroll
                    for (int e = 0; e < 4; ++e) h[4 * q + e] = v[j][4 * q + e] * rstd * nw[e] * (sc[e] + 1.0f) + sh[e]; }
                o8[64 * j] = cvt8_fp8(h);
                LAS f32x2* d = (LAS f32x2*)(hfs + li * P7_LD + 4 * c8); d[0] = (f32x2){h[0], h[1]}; d[1] = (f32x2){h[2], h[3]}; d[2] = (f32x2){h[4], h[5]}; d[3] = (f32x2){h[6], h[7]}; }
        }
    }
    __syncthreads();
    {
        const int i = lane & 15, kq = lane >> 4, k0 = 256 * wave + 32 * kq;
        const float* WrT = (const float*)(p.ws + WS_WRT);
        const float* w0 = WrT + (size_t)i * DM + k0; const float* w1 = WrT + (size_t)(16 + i) * DM + k0; const float* w2 = WrT + (size_t)(32 + i) * DM + k0;
        const LAS float* ap = hfs + i * P7_LD + k0;
        f32x4 a0 = {0.f, 0.f, 0.f, 0.f}, a1 = a0, a2 = a0;
#pragma unroll
        for (int blk = 0; blk < 4; ++blk) { const int ko = 128 * (blk >> 1) + 16 * (blk & 1);
            f32x4 b0[4], b1[4], b2[4]; f32x2 av[8];
#pragma unroll
            for (int q = 0; q < 4; ++q) { b0[q] = *(const f32x4*)(w0 + ko + 4 * q); b1[q] = *(const f32x4*)(w1 + ko + 4 * q); b2[q] = *(const f32x4*)(w2 + ko + 4 * q); }
#pragma unroll
            for (int q = 0; q < 8; ++q) av[q] = *(const LAS f32x2*)(ap + ko + 2 * q);
#pragma unroll
            for (int q = 0; q < 4; ++q)
#pragma unroll
                for (int e = 0; e < 4; ++e) { const float a = av[2 * q + (e >> 1)][e & 1];
                    a0 = __builtin_amdgcn_mfma_f32_16x16x4f32(a, b0[q][e], a0, 0, 0, 0);
                    a1 = __builtin_amdgcn_mfma_f32_16x16x4f32(a, b1[q][e], a1, 0, 0, 0);
                    a2 = __builtin_amdgcn_mfma_f32_16x16x4f32(a, b2[q][e], a2, 0, 0, 0); }
        }
        LAS f32x4* rw = (LAS f32x4*)red + (wave * 3) * 64 + lane; rw[0] = a0; rw[64] = a1; rw[128] = a2;
    }
    __syncthreads();
    if (tid < 256) {
        const int i = tid >> 4, n = tid & 15, src_lane = (i >> 2) * 16 + n, j = i & 3;
        LAS float* lgs = (LAS float*)(lds + 156160) + (slot * 16 + i) * 36;
#pragma unroll
        for (int tl = 0; tl < 3; ++tl) { float s = 0.f;
#pragma unroll
            for (int w = 0; w < 8; ++w) s += red[((w * 3 + tl) * 64 + src_lane) * 4 + j];
            if (tl == 0) { if (n < 4) lgs[n] = s; } else lgs[4 + (tl - 1) * 16 + n] = s; }
    }
}
__device__ __forceinline__ void p7_finish(const Params& p, LAS unsigned char* lds, int row_first, int row_stride, int nrows, int tid, int cnt_off) {
    unsigned* tok = (unsigned*)(p.ws + WS_TOK); unsigned* cnt = (unsigned*)(p.ws + WS_CTL) + CW_CNT + cnt_off;
    const LAS float* lgs = (const LAS float*)(lds + 156160); LAS unsigned* lcnt = (LAS unsigned*)(lds + 156160 + 4608); LAS unsigned* lbase = lcnt + 32;
    __syncthreads();
    int e0 = 0, e1 = 0; unsigned r0 = 0u, r1 = 0u; float w0 = 0.f, w1 = 0.f;
    if (tid < nrows) {
        const LAS float* L = lgs + tid * 36;
        float gl[4];
#pragma unroll
        for (int q = 0; q < 4; ++q) gl[q] = L[q] + p.b_rg[q];
        int gsel = 0; float gmax = gl[0];
#pragma unroll
        for (int q = 1; q < 4; ++q) if (gl[q] > gmax) { gmax = gl[q]; gsel = q; }
        float gden = 0.f;
#pragma unroll
        for (int q = 0; q < 4; ++q) gden += __expf(gl[q] - gmax);
        const float gwt = 1.0f / gden;
        float el[8];
#pragma unroll
        for (int q = 0; q < 8; ++q) el[q] = L[4 + gsel * 8 + q] + p.b_re[gsel * 8 + q];
        int i0 = 0; float v0 = el[0];
#pragma unroll
        for (int q = 1; q < 8; ++q) if (el[q] > v0) { v0 = el[q]; i0 = q; }
        int i1 = -1; float v1 = -3.0e38f;
#pragma unroll
        for (int q = 0; q < 8; ++q) if (q != i0 && el[q] > v1) { v1 = el[q]; i1 = q; }
        const float ex = __expf(v1 - v0); w0 = gwt / (1.0f + ex); w1 = gwt * ex / (1.0f + ex);
        e0 = gsel * 8 + i0; e1 = gsel * 8 + i1;
        r0 = __hip_atomic_fetch_add(lcnt + e0, 1u, __ATOMIC_RELAXED, __HIP_MEMORY_SCOPE_WORKGROUP); r1 = __hip_atomic_fetch_add(lcnt + e1, 1u, __ATOMIC_RELAXED, __HIP_MEMORY_SCOPE_WORKGROUP);
    }
    __syncthreads();
    if (tid < 32) { const unsigned c = lcnt[tid]; lbase[tid] = c ? atomicAdd(cnt + 64 * tid, c) : 0u; }
    __syncthreads();
    if (tid < nrows) { const size_t row = (size_t)row_first + (size_t)(tid >> 4) * row_stride + (tid & 15);
        u32x4 a; a.x = (unsigned)e0; a.y = lbase[e0] + r0; a.z = __float_as_uint(w0); a.w = (unsigned)e1; u32x4 c2; c2.x = lbase[e1] + r1; c2.y = __float_as_uint(w1); c2.z = 0u; c2.w = 0u;
        *(u32x4*)(tok + row * 8) = a; *(u32x4*)(tok + row * 8 + 4) = c2; }
    __syncthreads();
}
__device__ __forceinline__ int expert_offsets(const Params& p, int lane, int& padded, int& tot, int& cnt_out) {
    const unsigned* cnt = (const unsigned*)(p.ws + WS_CTL) + CW_CNT;
    const int ce = (int)__hip_atomic_load(cnt + 64 * (lane & 31), __ATOMIC_RELAXED, __HIP_MEMORY_SCOPE_AGENT);
    cnt_out = ce; padded = (ce + 255) & ~255; int off = 0, total = 0;
#pragma unroll
    for (int e = 0; e < 32; ++e) { const int pe = __builtin_amdgcn_readlane(padded, e); if (e < (lane & 31)) off += pe; total += pe; }
    tot = total;
    return off;
}
__device__ __forceinline__ void p8_rows(const Params& p, int gw, int NGW, int lane) {
    unsigned* tok = (unsigned*)(p.ws + WS_TOK); float* wslot = (float*)(p.ws + WS_WSLOT); int* s2t = (int*)(p.ws + WS_S2T);
    int padded, tot, ce; const int off = expert_offsets(p, lane, padded, tot, ce);
    for (int base = gw * 64; base < MTOK; base += NGW * 64) { const int row = base + lane;
        const u32x4 a = *(const u32x4*)(tok + (size_t)row * 8); const u32x4 c2 = *(const u32x4*)(tok + (size_t)row * 8 + 4);
        const int s0 = __builtin_amdgcn_ds_bpermute((int)a.x << 2, off) + (int)a.y, s1 = __builtin_amdgcn_ds_bpermute((int)a.w << 2, off) + (int)c2.x;
        tok[(size_t)row * 8 + 6] = (unsigned)s0; tok[(size_t)row * 8 + 7] = (unsigned)s1; wslot[s0] = __uint_as_float(a.z); wslot[s1] = __uint_as_float(c2.y);
        s2t[s0] = row; s2t[s1] = row; }
    for (int e = gw; e < NEXP; e += NGW) {
        const int o = __builtin_amdgcn_ds_bpermute(e << 2, off), c = __builtin_amdgcn_ds_bpermute(e << 2, ce), pd = __builtin_amdgcn_ds_bpermute(e << 2, padded);
        for (int i = c + lane; i < pd; i += 64) s2t[o + i] = 0; }
}
__device__ __forceinline__ void build_tile_table(const Params& p, LAS unsigned char* lds, int tid, int lane) {
    LAS int* tx = (LAS int*)(lds + TEXP_OFF);
    if (tid < 64) { int padded, tot, ce_; const int off = expert_offsets(p, lane, padded, tot, ce_);
        if (lane < 32) { const int t0 = off >> 8, nt = padded >> 8; for (int t = 0; t < nt; ++t) tx[1 + t0 + t] = lane; }
        if (lane == 0) tx[0] = tot >> 8; }
    __syncthreads();
}
template <bool GATH> struct MoeSched {
    static constexpr bool GATHER = GATH;
    const char* A; const char* W; const LAS int* tx; const int* s2t; int lda2x256, wtile, ntn, G, c;
    __device__ __forceinline__ bool next(int i, pg8::Unit& u) const {
        const int T = __builtin_amdgcn_readfirstlane(tx[0]);
        int t, nt;
        if ((G & 7) == 0) {
            const int x = c & 7, w = c >> 3, wpx = G >> 3, TPX = (T + 7) >> 3, li = i * wpx + w;
            const int j = li / ntn; nt = li - j * ntn; t = x * TPX + j; if (j >= TPX || t >= T) return false;
        } else { const int L = i * G + c; t = L / ntn; nt = L - t * ntn; if (t >= T) return false; }
        const int e = __builtin_amdgcn_readfirstlane(tx[1 + t]);
        u.a = GATH ? A : A + (size_t)t * lda2x256; u.b = W + (size_t)(e * ntn + nt) * wtile; u.i0 = t; u.i1 = nt; u.i2 = e; u.i3 = 0; return true;
    }
    __device__ __forceinline__ void rows(const pg8::Unit& u, const int (&R)[2], const int (&C)[2], unsigned (&g0)[2], unsigned (&g1)[2]) const {
        const int* l = s2t + u.i0 * 256;
#pragma unroll
        for (int i = 0; i < 2; ++i) { const unsigned t0 = (unsigned)l[R[i]], t1 = (unsigned)l[128 + R[i]]; g0[i] = t0 * (unsigned)DM + (unsigned)C[i] * 2u; g1[i] = t1 * (unsigned)DM + (unsigned)C[i] * 2u; }
    }
};
struct EpiGateUp {
    static constexpr bool PERM = true, CHAIN = false, AFTER_DRAIN = false;
    unsigned char* act;
    __device__ __forceinline__ void operator()(const f32x4 (&acc)[2][2][4][2], const pg8::Unit& u, int wr, int wc, int fr, int fq) const {
        asm volatile("" : "+v"(fr), "+v"(fq));
        const int col0 = 128 * u.i1 + 32 * wc + 8 * fq; const float ws = 1.0f / W8_SCALE;
#pragma unroll
        for (int ai = 0; ai < 2; ++ai)
#pragma unroll
            for (int m = 0; m < 4; ++m) { const size_t slot = (size_t)256 * u.i0 + 128 * ai + 64 * wr + 16 * m + fr;
                float r[8];
#pragma unroll
                for (int n = 0; n < 2; ++n)
#pragma unroll
                    for (int e = 0; e < 4; ++e) r[4 * n + e] = silu_f(acc[ai][0][m][n][e] * ws) * (acc[ai][1][m][n][e] * (ws * A8_SCALE));
                *(u32x2*)(act + slot * FF + col0) = cvt8_fp8(r); }
    }
};
struct EpiDown {
    static constexpr bool PERM = true, CHAIN = false, AFTER_DRAIN = false;
    bf16_t* y; const float* wslot;
    __device__ __forceinline__ void operator()(const f32x4 (&acc)[2][2][4][2], const pg8::Unit& u, int wr, int wc, int fr, int fq) const {
        asm volatile("" : "+v"(fr), "+v"(fq));
        const int col0 = 256 * u.i1 + 32 * wc + 8 * fq;
        float wsv[2][4];
#pragma unroll
        for (int ai = 0; ai < 2; ++ai)
#pragma unroll
            for (int m = 0; m < 4; ++m) wsv[ai][m] = wslot[(size_t)256 * u.i0 + 128 * ai + 64 * wr + 16 * m + fr];
#pragma unroll
        for (int ai = 0; ai < 2; ++ai)
#pragma unroll
            for (int m = 0; m < 4; ++m) { const size_t slot = (size_t)256 * u.i0 + 128 * ai + 64 * wr + 16 * m + fr; const float ws_ = wsv[ai][m] * (1.0f / (W8_SCALE * A8_SCALE));
#pragma unroll
                for (int bj = 0; bj < 2; ++bj) { const f32x4 v0 = acc[ai][bj][m][0] * ws_, v1 = acc[ai][bj][m][1] * ws_;
                    u32x4 w; w.x = cvt_pk_bf16(v0[0], v0[1]); w.y = cvt_pk_bf16(v0[2], v0[3]); w.z = cvt_pk_bf16(v1[0], v1[1]); w.w = cvt_pk_bf16(v1[2], v1[3]);
                    *(u32x4*)(y + slot * DM + col0 + 128 * bj) = w; } }
    }
};
__device__ __forceinline__ void p11_rows(const Params& p, int gw, int NGW, int lane) {
    const float* mod = (const float*)(p.ws + WS_MOD); const bf16_t* X1 = (const bf16_t*)(p.ws + WS_X1); const bf16_t* Y = (const bf16_t*)(p.ws + WS_Y); const unsigned* tok = (const unsigned*)(p.ws + WS_TOK);
    for (int row = gw; row < MTOK; row += NGW) {
        const int b = row >> 12;
        const u32x4* xr = (const u32x4*)(X1 + (size_t)row * DM) + lane;
        float v[4][8]; float s = 0.f;
#if DBG_MODE == 1
#pragma unroll
        for (int j = 0; j < 4; ++j) { const u32x4 w = xr[64 * j]; v[j][0] = bflo(w.x); v[j][1] = bfhi(w.x); v[j][2] = bflo(w.y); v[j][3] = bfhi(w.y); v[j][4] = bflo(w.z); v[j][5] = bfhi(w.z); v[j][6] = bflo(w.w); v[j][7] = bfhi(w.w); }
#else
        const int s0 = (int)tok[(size_t)row * 8 + 6], s1 = (int)tok[(size_t)row * 8 + 7];
        const u32x4* y0 = (const u32x4*)(Y + (size_t)s0 * DM) + lane; const u32x4* y1 = (const u32x4*)(Y + (size_t)s1 * DM) + lane;
#pragma unroll
        for (int j = 0; j < 4; ++j) { const int c8 = 2 * (64 * j + lane); const u32x4 w = __builtin_nontemporal_load(xr + 64 * j), a = __builtin_nontemporal_load(y0 + 64 * j), c2 = __builtin_nontemporal_load(y1 + 64 * j);
            const f32x4 g0 = ((const f32x4*)(mod + b * 12288 + 5 * 2048))[c8], g1 = ((const f32x4*)(mod + b * 12288 + 5 * 2048))[c8 + 1];
            v[j][0] = bflo(w.x) + g0[0] * (bflo(a.x) + bflo(c2.x)); v[j][1] = bfhi(w.x) + g0[1] * (bfhi(a.x) + bfhi(c2.x));
            v[j][2] = bflo(w.y) + g0[2] * (bflo(a.y) + bflo(c2.y)); v[j][3] = bfhi(w.y) + g0[3] * (bfhi(a.y) + bfhi(c2.y));
            v[j][4] = bflo(w.z) + g1[0] * (bflo(a.z) + bflo(c2.z)); v[j][5] = bfhi(w.z) + g1[1] * (bfhi(a.z) + bfhi(c2.z));
            v[j][6] = bflo(w.w) + g1[2] * (bflo(a.w) + bflo(c2.w)); v[j][7] = bfhi(w.w) + g1[3] * (bfhi(a.w) + bfhi(c2.w)); }
#endif
#pragma unroll
        for (int j = 0; j < 4; ++j)
#pragma unroll
            for (int e = 0; e < 8; ++e) s += v[j][e] * v[j][e];
        const float rstd = 1.0f / sqrtf(wave_sum(s) * (1.0f / DM) + NORM_EPS);
        f32x4* orow = (f32x4*)(p.out + (size_t)row * DM);
#pragma unroll
        for (int j = 0; j < 4; ++j) { const int c8 = 2 * (64 * j + lane); const f32x4 f0 = ((const f32x4*)p.final_norm_w)[c8], f1 = ((const f32x4*)p.final_norm_w)[c8 + 1];
            __builtin_nontemporal_store((f32x4){v[j][0] * rstd * f0[0], v[j][1] * rstd * f0[1], v[j][2] * rstd * f0[2], v[j][3] * rstd * f0[3]}, orow + c8);
            __builtin_nontemporal_store((f32x4){v[j][4] * rstd * f1[0], v[j][5] * rstd * f1[1], v[j][6] * rstd * f1[2], v[j][7] * rstd * f1[3]}, orow + c8 + 1); }
    }
}


constexpr int WARM_CODE_LINES = 5100;
__device__ __forceinline__ unsigned warm_touch(const Params& p, int idx) {
    unsigned w = 0;
#define WARM_BUF(ptr, mib) if (idx >= 0 && idx < (mib) * 16) w = *(const unsigned*)((const unsigned char*)(ptr) + ((size_t)idx << 16)); idx -= (mib) * 16;
    WARM_BUF(p.ws, (int)(WS_END >> 20)) WARM_BUF(p.x, 64) WARM_BUF(p.w_mod, 96) WARM_BUF(p.w_in, 56) WARM_BUF(p.w_out, 16) WARM_BUF(p.w_gate, 128) WARM_BUF(p.w_up, 128) WARM_BUF(p.w_down, 128)
    WARM_BUF(p.out, 64) WARM_BUF(p.ctx, 4)
#undef WARM_BUF
    return w;
}
constexpr int WARM_TOUCHES = ((int)(WS_END >> 20) + 64 + 96 + 56 + 16 + 128 + 128 + 128 + 64 + 4) * 16;

__global__ void __launch_bounds__(NWAVES * 64, 2) fwd_megakernel(Params p) {
    extern __shared__ __attribute__((aligned(16))) unsigned char lds_raw[];
    LAS unsigned char* lds = (LAS unsigned char*)lds_raw;
    const int G = gridDim.x, bx = blockIdx.x;
    const int vcu = (G % 8 == 0) ? (bx % 8) * (G / 8) + bx / 8 : bx;
    const int NGW = G * NWAVES;
    const int wave_s = __builtin_amdgcn_readfirstlane((int)threadIdx.x >> 6);
#define FRESH_IDS() int lane; asm volatile("v_mbcnt_lo_u32_b32 %0, -1, 0\n\tv_mbcnt_hi_u32_b32 %0, -1, %0" : "=v"(lane)); const int wave = wave_s, tid = wave * 64 + lane, gw = vcu * NWAVES + wave; (void)tid; (void)gw
    volatile LAS unsigned* MISC = (volatile LAS unsigned*)(lds + MISC_OFF);
    { FRESH_IDS(); for (int u = tid; u < (LDS_BYTES - CTL_OFF) / 4; u += NWAVES * 64) ((LAS unsigned*)(lds + CTL_OFF))[u] = 0u; }
    __syncthreads();
    unsigned* ctl = (unsigned*)(p.ws + WS_CTL);
    XcdBarrier bar = xcd_barrier_post(ctl + CW_BAR, MISC + 8);

    _Pragma("unroll 1") for (int rep_ = 0; rep_ < ((REP & 1) ? 2 : 1); ++rep_) {
    if (PHASES & 1) { FRESH_IDS();
        unsigned warm = 0;
        if (rep_ == 0) { const int t = (bx >> 3) * (NWAVES * 64) + tid, nt = ((G + 7) >> 3) * (NWAVES * 64);
            const unsigned char* code = (const unsigned char*)(__builtin_amdgcn_s_getpc() & ~255ull);
            for (int l = t; l < WARM_CODE_LINES; l += nt) warm ^= *(const unsigned*)(code + (size_t)l * 64);
            for (int i = t; i < WARM_TOUCHES; i += nt) warm ^= warm_touch(p, i); }
        if (bx < 192) p0_mod_item(p, lds, bx, tid, wave, lane);
        { float* WrT = (float*)(p.ws + WS_WRT); for (int idx = gw * 64 + lane; idx < 48 * 2048; idx += NGW * 64) { const int c = idx >> 11, k = idx & 2047;
            WrT[idx] = c < 4 ? p.w_rg[k * 4 + c] : (c < 16 ? 0.f : p.w_re[((size_t)((c - 16) >> 3) * DM + k) * 8 + ((c - 16) & 7)]); } }
        conv_range(p, lds, 0, CV_P3, gw, NGW, wave, lane);
        asm volatile("" :: "v"(warm));
        if (wave == 0) { unsigned* rdy = (unsigned*)(p.ws + WS_CTL) + CW_MODRDY; unsigned sp = 0;
            while ((unsigned)__builtin_amdgcn_readfirstlane(__hip_atomic_load(rdy, __ATOMIC_RELAXED, __HIP_MEMORY_SCOPE_AGENT)) < 192u && ++sp < (1u << 22)) __builtin_amdgcn_s_sleep(2);
            __builtin_amdgcn_fence(__ATOMIC_ACQUIRE, "agent"); asm volatile("s_waitcnt vmcnt(0)" ::: "memory"); }
        __syncthreads(); }
    }
    _Pragma("unroll 1") for (int rep_ = 0; rep_ < ((REP & 2) ? 2 : 1); ++rep_) {
    if (PHASES & 2) { FRESH_IDS(); p1_rows(p, gw, NGW, lane); }
    xcd_barrier(bar);
    }
    _Pragma("unroll 1") for (int rep_ = 0; rep_ < ((REP & 4) ? 2 : 1); ++rep_) {
    if (PHASES & 4) {
        InProjSched S{(const char*)(p.ws + WS_HX), (const char*)(p.ws + WS_WIN), G, bx};
        EpiInProj E{p.ws, p.ret_decay_f, p.ret_decay_b};
        pg8::gemm_phase<EpiInProj, InProjSched, true>(lds, wave_s, DM, DM, DM, S, E);
        InProjSched8 S8{(const char*)(p.ws + WS_X1), (const char*)(p.ws + WS_WIN), G - 16, bx - 16};
        pg8::gemm_phase<EpiInProj, InProjSched8, true, 1>(lds, wave_s, DM, DM, DM / 2, S8, E);
        if (rep_ == 0 && bx >= 176 && G == 256) { FRESH_IDS(); conv_range(p, lds, CV_P0, CV_P2, (bx - 176) * NWAVES + wave, 80 * NWAVES, wave, lane); }
        else if (rep_ == 0 && G != 256) { FRESH_IDS(); conv_range(p, lds, CV_P0, CV_P2, gw, NGW, wave, lane); }
    }
    xcd_barrier(bar);
    }
    _Pragma("unroll 1") for (int rep_ = 0; rep_ < ((REP & 24) ? 2 : 1); ++rep_) {
    if (bx < 16) {
        if ((PHASES & 16) && (rep_ == 0 || (REP & 16))) {
        const int dir = bx & 1, bh = bx >> 1, h = bh & 3;
        const char* svp = (const char*)(p.ws + WS_SV) + ((size_t)bh * 16 * 256 * 768 + 512) * 2;
        const char* svcp = (const char*)(p.ws + WS_SVC) + ((size_t)bh * 256 * 768 + 512) * 2;
        const char* kTp = (const char*)(p.ws + (dir == 0 ? WS_KTF : WS_KTB)) + (size_t)bh * 256 * LDT * 2;
        ChainSched S{svp, svcp, kTp, dir};
        const float lg = log2_sigmoid(dir == 0 ? p.ret_decay_f[h] : p.ret_decay_b[h]);
        EpiChain E{(bf16_t*)(p.ws + WS_SV) + (size_t)bh * 16 * 256 * 768, dir, exp2f(lg * 256.0f)};
        pg8::gemm_phase<EpiChain, ChainSched, true>(lds, wave_s, 768, LDT, 256, S, E); }
    } else {
#if DBG_MODE != 3
        if ((PHASES & 32) && rep_ == 0) {
            ScoreSched S{(const char*)(p.ws + WS_Q), (const char*)(p.ws + WS_K), bx < 144 ? bx - 16 : -1};
            EpiScore E{(bf16_t*)(p.ws + WS_QP), p.ret_decay_f, p.ret_decay_b};
            pg8::gemm_phase<EpiScore, ScoreSched, true>(lds, wave_s, 1024, 1024, 256, S, E); }
        if ((PHASES & 8) && (rep_ == 0 || (REP & 8))) { FRESH_IDS();
        if (G == 256) {
            const int xl = bx & 7, vl = (bx >> 3) - 2; for (int item = 128 * xl + vl; item < 128 * xl + 128; item += 30) na_wg_item(p, lds, item, wave, lane);
            if (rep_ == 0) conv_range(p, lds, CV_P3, CV_P0, (bx - 16) * NWAVES + wave, 240 * NWAVES, wave, lane);
        } else { for (int item = bx - 16; item < 1024; item += G - 16) na_wg_item(p, lds, item, wave, lane);
            if (rep_ == 0) conv_range(p, lds, CV_P3, CV_P0, (bx - 16) * NWAVES + wave, (G - 16) * NWAVES, wave, lane); } }
#endif
    }
    xcd_barrier(bar);
    }
    _Pragma("unroll 1") for (int rep_ = 0; rep_ < ((REP & 32) ? 2 : 1); ++rep_) {
#if DBG_MODE != 2
    if (PHASES & 32) {
        RetOutSched S{(const char*)(p.ws + WS_QP), (const char*)(p.ws + WS_SV), bx < 128 ? bx : -1};
        EpiRetOut E{(const bf16_t*)(p.ws + WS_G), p.ret_gn_w, (bf16_t*)(p.ws + WS_MIX)};
        pg8::gemm_phase<EpiRetOut, RetOutSched, true>(lds, wave_s, 768, 768, 768, S, E);
        if (rep_ == 0 && bx >= 128 && G == 256) { FRESH_IDS(); conv_range(p, lds, CV_P2, CV_P9, (bx - 128) * NWAVES + wave, 128 * NWAVES, wave, lane); }
        else if (rep_ == 0 && G != 256) { FRESH_IDS(); conv_range(p, lds, CV_P2, CV_P9, gw, NGW, wave, lane); } }
#endif
    xcd_barrier(bar);
    }
    _Pragma("unroll 1") for (int rep_ = 0; rep_ < ((REP & 64) ? 2 : 1); ++rep_) {
    if (PHASES & 64) {
        OutProjSched S{(const char*)(p.ws + WS_MIX), (const char*)(p.ws + WS_WOUT), G, bx};
        EpiOutProj E{p.x, (const float*)(p.ws + WS_MOD), (bf16_t*)(p.ws + WS_X1)};
        pg8::gemm_phase<EpiOutProj, OutProjSched, true, 1>(lds, wave_s, DM, DM, DM / 2, S, E);
    }
    xcd_barrier(bar);
    }
#if DBG_MODE != 1
    _Pragma("unroll 1") for (int rep_ = 0; rep_ < ((REP & 128) ? 2 : 1); ++rep_) {
    if (PHASES & 128) { FRESH_IDS(); if (tid < 32) ((LAS unsigned*)(lds + 156160 + 4608))[tid] = 0u;
        int slot = 0; for (int item = bx; item < 512 && slot < 2; item += G, ++slot) p7_item(p, lds, item, slot, tid, wave, lane);
        p7_finish(p, lds, 16 * bx, 16 * G, 16 * slot, tid, ((REP & 128) && rep_ == 0) ? 4096 : 0); }
    xcd_barrier(bar);
    }
    _Pragma("unroll 1") for (int rep_ = 0; rep_ < ((REP & 256) ? 2 : 1); ++rep_) {
    if (PHASES & 256) { FRESH_IDS(); p8_rows(p, gw, NGW, lane);
        build_tile_table(p, lds, tid, lane); }
    xcd_barrier(bar);
    }
    _Pragma("unroll 1") for (int rep_ = 0; rep_ < ((REP & 512) ? 2 : 1); ++rep_) {
    if (PHASES & 512) {
        MoeSched<true> S{(const char*)(p.ws + WS_HF), (const char*)(p.ws + WS_WGU), (const LAS int*)(lds + TEXP_OFF), (const int*)(p.ws + WS_S2T), 256 * DM, 256 * DM, 4, G, bx};
        EpiGateUp E{p.ws + WS_ACT};
        pg8::gemm_phase<EpiGateUp, MoeSched<true>, true, 1>(lds, wave_s, DM / 2, DM / 2, DM / 2, S, E);
        if (rep_ == 0) { FRESH_IDS(); const int T9 = ((const LAS int*)(lds + TEXP_OFF))[0];
            if ((G & 7) == 0) { const int wpx = G >> 3, TPX = (T9 + 7) >> 3, x = bx & 7, w = bx >> 3; int before = 0, total = 0, hw_me = 0;
                for (int xx = 0; xx < 8; ++xx) { const int tiles = min(max(T9 - xx * TPX, 0), TPX), hw = min(max(4 * tiles - wpx, 0), wpx); if (xx < x) before += wpx - hw; if (xx == x) hw_me = hw; total += wpx - hw; }
                if (total == 0) conv_range(p, lds, CV_P9, NCONV, gw, NGW, wave, lane);
                else if (w >= hw_me) conv_range(p, lds, CV_P9, NCONV, (before + w - hw_me) * NWAVES + wave, total * NWAVES, wave, lane);
            } else { const int n9 = 4 * T9, heavy = min(max(n9 - G, 0), G - 1); if (bx >= heavy) conv_range(p, lds, CV_P9, NCONV, (bx - heavy) * NWAVES + wave, (G - heavy) * NWAVES, wave, lane); } }
    }
    xcd_barrier(bar);
    }
    _Pragma("unroll 1") for (int rep_ = 0; rep_ < ((REP & 1024) ? 2 : 1); ++rep_) {
    if (PHASES & 1024) {
        MoeSched<false> S{(const char*)(p.ws + WS_ACT), (const char*)(p.ws + WS_WD), (const LAS int*)(lds + TEXP_OFF), nullptr, 256 * FF, 256 * FF, 8, G, bx};
        EpiDown E{(bf16_t*)(p.ws + WS_Y), (const float*)(p.ws + WS_WSLOT)};
        pg8::gemm_phase<EpiDown, MoeSched<false>, true, 1>(lds, wave_s, FF / 2, FF / 2, FF / 2, S, E);
    }
    xcd_barrier(bar);
    }
#endif
    _Pragma("unroll 1") for (int rep_ = 0; rep_ < ((REP & 2048) ? 2 : 1); ++rep_) {
    if (PHASES & 2048) { FRESH_IDS(); p11_rows(p, gw, NGW, lane); }
    }
#undef FRESH_IDS
}

extern "C" void kernel_launch(void* const* d_in, const int* in_sizes, int n_in, void* d_out, int out_size, void* d_ws, size_t ws_size, hipStream_t stream) {
    static int grid = 0;
    if (grid == 0) {
        if (n_in != 22 || ws_size < WS_END) { fprintf(stderr, "kernel_launch: unexpected inputs (n_in %d, ws %zu, need %zu)\n", n_in, ws_size, (size_t)WS_END); grid = -1; return; }
        int dev = 0, cus = 0;
        if (hipGetDevice(&dev) != hipSuccess || hipDeviceGetAttribute(&cus, hipDeviceAttributeMultiprocessorCount, dev) != hipSuccess) { grid = -1; return; }
        if (hipFuncSetAttribute((const void*)fwd_megakernel, hipFuncAttributeMaxDynamicSharedMemorySize, LDS_BYTES) != hipSuccess) { fprintf(stderr, "kernel_launch: hipFuncSetAttribute failed\n"); grid = -1; return; }
        (void)hipGetLastError();
        grid = cus;
    }
    if (grid < 0) return;
    (void)hipMemsetAsync((char*)d_ws + WS_CTL, 0, CTL_ZERO_BYTES, stream);
    Params p{};
    const float** pp = (const float**)&p;
    for (int i = 0; i < 22; ++i) pp[i] = (const float*)d_in[i];
    p.out = (float*)d_out; p.ws = (unsigned char*)d_ws;
    hipLaunchKernelGGL(fwd_megakernel, dim3(grid), dim3(NWAVES * 64), LDS_BYTES, stream, p);
}
```

```cpp
#include <hip/hip_runtime.h>
#include <cstdio>
#include <cstdint>

#define LAS __attribute__((address_space(3)))
#define GAS __attribute__((address_space(1)))
typedef unsigned short bf16_t;
typedef short bf16x8 __attribute__((ext_vector_type(8)));
typedef short s16x4 __attribute__((ext_vector_type(4)));
typedef float f32x4 __attribute__((ext_vector_type(4)));
typedef float f32x2 __attribute__((ext_vector_type(2)));
typedef unsigned u32x4 __attribute__((ext_vector_type(4)));
typedef unsigned u32x2 __attribute__((ext_vector_type(2)));

#ifndef PHASES
#define PHASES 0xFFFF
#endif
#ifndef REP
#define REP 0
#endif
#ifndef DBG_MODE
#define DBG_MODE 0
#endif

constexpr int DM = 2048, SEQ = 4096, MTOK = 8192, CTXL = 256, MALL = 8704, NIN = 7168;
constexpr int LDT = 4352;
constexpr int NEXP = 32, FF = 512, MAXSLOT = 24576;
constexpr float NORM_EPS = 1e-6f;
constexpr float LOG2E = 1.4426950408889634f;

constexpr size_t MiB = 1u << 20;
constexpr size_t WS_CTL = 0, CTL_ZERO_BYTES = 65536;
constexpr size_t WS_MOD = 1 * MiB;
constexpr size_t WS_TOK = 2 * MiB;
constexpr size_t WS_WSLOT = 2 * MiB + 512 * 1024;
constexpr size_t WS_S2T = 3 * MiB;
constexpr size_t WS_WRT = 3 * MiB + 512 * 1024;
constexpr size_t WS_WIN = 4 * MiB, WS_WOUT = 32 * MiB, WS_WGU = 40 * MiB, WS_WD = 168 * MiB, WS_X1 = 232 * MiB;
constexpr size_t WS_E = 296 * MiB;
constexpr size_t WS_HX = WS_E, WS_Q = WS_E + 34 * MiB, WS_K = WS_E + 50 * MiB, WS_G = WS_E + 66 * MiB, WS_NQ = WS_E + 82 * MiB, WS_NK = WS_E + 98 * MiB;
constexpr size_t WS_KTF = WS_E + 115 * MiB, WS_KTB = WS_E + 132 * MiB, WS_NVT = WS_E + 149 * MiB;
constexpr size_t WS_SV = WS_E + 166 * MiB;
constexpr size_t WS_SVC = WS_E + 214 * MiB;
constexpr size_t WS_QP = WS_E + 217 * MiB;
constexpr size_t WS_MIX = WS_E + 265 * MiB;
constexpr size_t WS_HF = WS_E, WS_HFS = WS_E + 32 * MiB, WS_ACT = WS_E + 128 * MiB, WS_Y = WS_E + 152 * MiB;
constexpr size_t WS_END = WS_E + 297 * MiB;
constexpr int CW_BAR = 4096, CW_CNT = 8192, CW_MODRDY = 12288;

constexpr int RING_BYTES = 131072, CTL_OFF = 161792, MISC_OFF = CTL_OFF + 320, TEXP_OFF = CTL_OFF + 1024, LDS_BYTES = 163840;
constexpr int NWAVES = 8;

__device__ __forceinline__ unsigned cvt_pk_bf16(float lo, float hi) { unsigned r; asm volatile("v_cvt_pk_bf16_f32 %0, %1, %2" : "=v"(r) : "v"(lo), "v"(hi)); return r; }
typedef int v8i __attribute__((ext_vector_type(8)));
typedef int v4i __attribute__((ext_vector_type(4)));
constexpr float W8_SCALE = 64.0f, A8_SCALE = 8.0f, MIX8_SCALE = 16.0f;
__device__ __forceinline__ u32x2 cvt8_fp8(const float (&h)[8]) { int lo = __builtin_amdgcn_cvt_pk_fp8_f32(h[0], h[1], 0, false); lo = __builtin_amdgcn_cvt_pk_fp8_f32(h[2], h[3], lo, true);
    int hi = __builtin_amdgcn_cvt_pk_fp8_f32(h[4], h[5], 0, false); hi = __builtin_amdgcn_cvt_pk_fp8_f32(h[6], h[7], hi, true); u32x2 r; r.x = (unsigned)lo; r.y = (unsigned)hi; return r; }
__device__ __forceinline__ float bf2f(unsigned short h) { return __uint_as_float((unsigned)h << 16); }
__device__ __forceinline__ float bflo(unsigned w) { return __uint_as_float(w << 16); }
__device__ __forceinline__ float bfhi(unsigned w) { return __uint_as_float(w & 0xffff0000u); }
template <int X> __device__ __forceinline__ float lane_xor(float v) { return __int_as_float(__builtin_amdgcn_ds_swizzle(__float_as_int(v), (X << 10) | 0x1f)); }
__device__ __forceinline__ float half_sum(float v) { const auto r = __builtin_amdgcn_permlane32_swap(__float_as_uint(v), __float_as_uint(v), false, false); return __uint_as_float(r[0]) + __uint_as_float(r[1]); }
__device__ __forceinline__ float half_max(float v) { const auto r = __builtin_amdgcn_permlane32_swap(__float_as_uint(v), __float_as_uint(v), false, false); return fmaxf(__uint_as_float(r[0]), __uint_as_float(r[1])); }
__device__ __forceinline__ float sum_g4(float v) { v += lane_xor<16>(v); return half_sum(v); }
__device__ __forceinline__ float max_g4(float v) { v = fmaxf(v, lane_xor<16>(v)); return half_max(v); }
__device__ __forceinline__ float wave_sum(float v) { v += lane_xor<1>(v); v += lane_xor<2>(v); v += lane_xor<4>(v); v += lane_xor<8>(v); v += lane_xor<16>(v); return half_sum(v); }
__device__ __forceinline__ float silu_f(float x) { return x * __builtin_amdgcn_rcpf(1.0f + __expf(-x)); }
__device__ __forceinline__ void sincos_ang(float ang, float& s, float& c) { float rev = ang * 0.15915494309189535f; rev = rev - floorf(rev); s = __builtin_amdgcn_sinf(rev); c = __builtin_amdgcn_cosf(rev); }
__device__ __forceinline__ float log2_sigmoid(float x) { return -log1pf(__expf(-x)) * LOG2E; }
#define LDS_WAIT() asm volatile("s_waitcnt lgkmcnt(0)" ::: "memory")
#define VM_WAIT() asm volatile("s_waitcnt vmcnt(0)" ::: "memory")

namespace pg8 {
constexpr int BM = 256, BK = 64, HALF = 128, HTB = HALF * BK * 2, STAGE_BYTES = 8 * HTB;
__device__ __forceinline__ int lds_byte(int r, int c) { const int st = (r >> 4) * 2 + (c >> 5), rr = r & 15, cc = c & 31, ob = rr * 64 + cc * 2; return st * 1024 + (ob ^ (((ob >> 9) & 1) << 5)); }
__device__ __forceinline__ void stage_rc(int b, int& R, int& C) { const int st = b / 1024, sb = b % 1024, swz = sb ^ (((sb >> 9) & 1) << 5); R = (st >> 1) * 16 + swz / 64; C = (st & 1) * 32 + (swz % 64) / 2; }
__device__ __forceinline__ int perm32(int rho) { const int n = rho >> 4, i = rho & 15; return 8 * (i >> 2) + 4 * n + (i & 3); }

struct Unit { const char* a; const char* b; int i0, i1, i2, i3; };

template <class Epi, class Sched, bool ALIGN_EPI, int MX = 0, int MH = 0>
__device__ __forceinline__ void gemm_phase(LAS unsigned char* lds, const int wid, const int lda, const int ldb, const int K, const Sched& S, const Epi& E) {
    int lane; asm volatile("v_mbcnt_lo_u32_b32 %0, -1, 0\n\tv_mbcnt_hi_u32_b32 %0, -1, %0" : "=v"(lane));
    const int tid = wid * 64 + lane, wr = wid >> 2, wc = wid & 3, fr = lane & 15, fq = lane >> 4;
    const int nt = K / BK;
    unsigned voffA[2], voffB[2]; int RA[2], CA[2];
#pragma unroll
    for (int i = 0; i < 2; ++i) { int R, C; stage_rc(tid * 16 + i * 8192, R, C); const int Rb = Epi::PERM ? ((R & ~31) + perm32(R & 31)) : R; RA[i] = R; CA[i] = C;
        voffA[i] = (unsigned)(R * lda + C) * 2u; voffB[i] = (unsigned)(Rb * ldb + C) * 2u; }
    unsigned gc0[2] = {0u, 0u}, gc1[2] = {0u, 0u}, gn0[2] = {0u, 0u}, gn1[2] = {0u, 0u};
    const size_t kstep = (size_t)(BK * 2);
    const size_t hstepA = (Sched::GATHER || MH) ? (size_t)0 : (size_t)HALF * lda * 2, hstepB = (size_t)HALF * ldb * 2;
    const unsigned ldsw = (unsigned)wid * 1024u;
    const int aoff = lds_byte(wr * 64 + fr, fq * 8), boff = lds_byte(wc * 32 + fr, fq * 8);
#define PG8_SA(b, h) (((b) * 2 + (h)) * HTB)
#define PG8_SB(b, h) ((4 + (b) * 2 + (h)) * HTB)
#define PG8_STAGE(bufoff, gbase, voff) do { _Pragma("unroll") for (int _i = 0; _i < 2; ++_i) \
        __builtin_amdgcn_global_load_lds((const unsigned*)((const char*)(gbase) + (voff)[_i]), (LAS unsigned*)(lds + (bufoff) + ldsw + _i * 8192), 16, 0, 0); } while (0)
#define PG8_LDS16(off) (*(const LAS v4i*)(lds + (off)))
#define PG8_LDA(dst, b, h) do { if constexpr (MX == 0) { _Pragma("unroll") for (int m = 0; m < 4; ++m) _Pragma("unroll") for (int k = 0; k < 2; ++k) dst[m][k] = *(const LAS bf16x8*)(lds + PG8_SA(b, h) + aoff + m * 2048 + k * 1024); } \
        else { _Pragma("unroll") for (int m = 0; m < 4; ++m) dst##8[m] = __builtin_shufflevector(PG8_LDS16(PG8_SA(b, h) + aoff + m * 2048), PG8_LDS16(PG8_SA(b, h) + aoff + m * 2048 + 1024), 0, 1, 2, 3, 4, 5, 6, 7); } } while (0)
#define PG8_LDB(dst, b, h) do { if constexpr (MX == 0) { _Pragma("unroll") for (int n = 0; n < 2; ++n) _Pragma("unroll") for (int k = 0; k < 2; ++k) dst[n][k] = *(const LAS bf16x8*)(lds + PG8_SB(b, h) + boff + n * 2048 + k * 1024); } \
        else { _Pragma("unroll") for (int n = 0; n < 2; ++n) dst##8[n] = __builtin_shufflevector(PG8_LDS16(PG8_SB(b, h) + boff + n * 2048), PG8_LDS16(PG8_SB(b, h) + boff + n * 2048 + 1024), 0, 1, 2, 3, 4, 5, 6, 7); } } while (0)
#define PG8_MMA(ai, bj, At, Bt) do { __builtin_amdgcn_s_setprio(1); if constexpr (MX == 0) { _Pragma("unroll") for (int m = 0; m < 4; ++m) _Pragma("unroll") for (int n = 0; n < 2; ++n) _Pragma("unroll") for (int k = 0; k < 2; ++k) \
        acc[ai][bj][m][n] = __builtin_amdgcn_mfma_f32_16x16x32_bf16(Bt[n][k], At[m][k], acc[ai][bj][m][n], 0, 0, 0); } else { _Pragma("unroll") for (int m = 0; m < 4; ++m) _Pragma("unroll") for (int n = 0; n < 2; ++n) \
        asm volatile("v_mfma_scale_f32_16x16x128_f8f6f4 %0, %1, %2, %0, %3, %3 op_sel_hi:[0,0,0]" : "+v"(acc[ai][bj][m][n]) : "v"(Bt##8[n]), "v"(At##8[m]), "v"(mxs1)); } \
        __builtin_amdgcn_s_setprio(0); } while (0)
#define PG8_WAIT_V(n) asm volatile("s_waitcnt vmcnt(" #n ")" ::: "memory")
#define PG8_WAIT_L(n) asm volatile("s_waitcnt lgkmcnt(" #n ")" ::: "memory")
#define PG8_BAR __builtin_amdgcn_s_barrier()
#define PG8_SCHED __builtin_amdgcn_sched_barrier(0)
    Unit cur, nxt; int ui = 0;
    if (!S.next(0, cur)) return;
    f32x4 acc[2][2][4][2];
#pragma unroll
    for (int a = 0; a < 2; ++a)
#pragma unroll
        for (int b = 0; b < 2; ++b)
#pragma unroll
            for (int m = 0; m < 4; ++m)
#pragma unroll
                for (int n = 0; n < 2; ++n) acc[a][b][m][n] = (f32x4){0.f, 0.f, 0.f, 0.f};
    bf16x8 At[4][2], B0[2][2], B1[2][2];
    v8i At8[4], B08[2], B18[2];
    const int mxs1 = 0x7F7F7F7F;
    const char* cA = cur.a; const char* cB = cur.b;
    if constexpr (Sched::GATHER) S.rows(cur, RA, CA, gc0, gc1);
#define PG8_VA0C (Sched::GATHER ? gc0 : voffA)
#define PG8_VA1C (Sched::GATHER ? gc1 : voffA)
    PG8_STAGE(PG8_SB(0, 0), cB, voffB); PG8_STAGE(PG8_SB(0, 1), cB + hstepB, voffB); PG8_STAGE(PG8_SA(0, 0), cA, PG8_VA0C); PG8_STAGE(PG8_SA(0, 1), cA + hstepA, PG8_VA1C);
    if (wr == 1) PG8_BAR;
    PG8_WAIT_V(2); PG8_BAR;
    PG8_STAGE(PG8_SB(1, 0), cB + kstep, voffB); PG8_STAGE(PG8_SA(1, 0), cA + kstep, PG8_VA0C); PG8_STAGE(PG8_SB(1, 1), cB + hstepB + kstep, voffB);
    PG8_WAIT_V(6); PG8_BAR;
    for (;;) {
        const bool has_next = S.next(ui + 1, nxt);
        const char* nA = has_next ? nxt.a : cA; const char* nB = has_next ? nxt.b : cB;
        if constexpr (Sched::GATHER) { if (has_next) S.rows(nxt, RA, CA, gn0, gn1); else { gn0[0] = gc0[0]; gn0[1] = gc0[1]; gn1[0] = gc1[0]; gn1[1] = gc1[1]; } }
#pragma unroll 1
        for (int t = 0; t < nt; t += 2) {
            const bool last = (t == nt - 2);
            const char* a1 = cA + (size_t)(t + 1) * kstep;
            const char* a2 = last ? nA : cA + (size_t)(t + 2) * kstep; const char* b2 = last ? nB : cB + (size_t)(t + 2) * kstep;
            const char* a3 = a2 + kstep; const char* b3 = b2 + kstep;
            unsigned gs0[2], gs1[2];
            if constexpr (Sched::GATHER) { gs0[0] = last ? gn0[0] : gc0[0]; gs0[1] = last ? gn0[1] : gc0[1]; gs1[0] = last ? gn1[0] : gc1[0]; gs1[1] = last ? gn1[1] : gc1[1]; }
#define PG8_VA0S (Sched::GATHER ? gs0 : voffA)
#define PG8_VA1S (Sched::GATHER ? gs1 : voffA)
            PG8_LDB(B0, 0, 0); PG8_LDB(B1, 0, 1); PG8_SCHED; PG8_LDA(At, 0, 0); PG8_STAGE(PG8_SA(1, 1), a1 + hstepA, PG8_VA1C);
            PG8_WAIT_V(8); PG8_WAIT_L(0); PG8_BAR; PG8_MMA(0, 0, At, B0); PG8_MMA(0, 1, At, B1); PG8_BAR; PG8_SCHED;
            if constexpr (!MH) PG8_LDA(At, 0, 1);
            PG8_STAGE(PG8_SB(0, 0), b2, voffB); PG8_STAGE(PG8_SB(0, 1), b2 + hstepB, voffB); PG8_STAGE(PG8_SA(0, 0), a2, PG8_VA0S);
            PG8_WAIT_V(8); PG8_WAIT_L(0); PG8_BAR; if constexpr (!MH) { PG8_MMA(1, 0, At, B0); PG8_MMA(1, 1, At, B1); } PG8_BAR; PG8_SCHED;
            PG8_LDB(B0, 1, 0); PG8_LDB(B1, 1, 1); PG8_SCHED; PG8_LDA(At, 1, 0); PG8_STAGE(PG8_SA(0, 1), a2 + hstepA, PG8_VA1S);
            PG8_WAIT_V(8); PG8_WAIT_L(0); PG8_BAR; PG8_MMA(0, 0, At, B0); PG8_MMA(0, 1, At, B1); PG8_BAR; PG8_SCHED;
            if constexpr (!MH) PG8_LDA(At, 1, 1);
            PG8_STAGE(PG8_SB(1, 0), b3, voffB); PG8_STAGE(PG8_SB(1, 1), b3 + hstepB, voffB); PG8_STAGE(PG8_SA(1, 0), a3, PG8_VA0S);
            PG8_WAIT_V(8); PG8_WAIT_L(0); PG8_BAR; if constexpr (!MH) { PG8_MMA(1, 0, At, B0); PG8_MMA(1, 1, At, B1); } PG8_BAR; PG8_SCHED;
        }
        if constexpr (MX != 0) asm volatile("s_nop 15\n\ts_nop 15" ::: "memory");
        if constexpr (ALIGN_EPI) { if (wr == 0) PG8_BAR; }
        if constexpr (!Epi::AFTER_DRAIN) E(acc, cur, wr, wc, fr, fq);
        if (!has_next) break;
        float csc = 0.f;
        if constexpr (Epi::CHAIN) csc = E.chain_scale(cur);
        if (csc == 0.f) {
#pragma unroll
            for (int a = 0; a < 2; ++a)
#pragma unroll
                for (int b = 0; b < 2; ++b)
#pragma unroll
                    for (int m = 0; m < 4; ++m)
#pragma unroll
                        for (int n = 0; n < 2; ++n) acc[a][b][m][n] = (f32x4){0.f, 0.f, 0.f, 0.f};
        } else {
#pragma unroll
            for (int a = 0; a < 2; ++a)
#pragma unroll
                for (int b = 0; b < 2; ++b)
#pragma unroll
                    for (int m = 0; m < 4; ++m)
#pragma unroll
                        for (int n = 0; n < 2; ++n) acc[a][b][m][n] = acc[a][b][m][n] * csc;
        }
        cur = nxt; cA = nA; cB = nB; ++ui;
        if constexpr (Sched::GATHER) { gc0[0] = gn0[0]; gc0[1] = gn0[1]; gc1[0] = gn1[0]; gc1[1] = gn1[1]; }
        if constexpr (ALIGN_EPI) { if (wr == 1) PG8_BAR; }
    }
    PG8_WAIT_V(0);
    if constexpr (!ALIGN_EPI) { if (wr == 0) PG8_BAR; }
    PG8_BAR;
    if constexpr (Epi::AFTER_DRAIN) E.fused(acc, cur, wr, wc, fr, fq, lds);
#undef PG8_VA0C
#undef PG8_VA1C
#undef PG8_VA0S
#undef PG8_VA1S
#undef PG8_SA
#undef PG8_SB
#undef PG8_STAGE
#undef PG8_LDA
#undef PG8_LDB
#undef PG8_MMA
#undef PG8_LDS16
#undef PG8_WAIT_V
#undef PG8_WAIT_L
#undef PG8_BAR
#undef PG8_SCHED
}
}

#define XB_TMO      128
#define XB_XCNT(j)  (256  + 64 * (j))
#define XB_XSUB(j)  (1280 + 64 * (j))
#define XB_XGEN(j)  (2304 + 64 * (j))
#define XB_TOP      3328
#define XB_TOPGEN   3392
#define XCD_BAR_WORDS 3456
#define XB_SPIN_CAP (1u << 18)
__device__ __forceinline__ unsigned xb_ld(unsigned* p)              { return __hip_atomic_load(p, __ATOMIC_RELAXED, __HIP_MEMORY_SCOPE_AGENT); }
__device__ __forceinline__ unsigned xb_add(unsigned* p, unsigned v) { return __hip_atomic_fetch_add(p, v, __ATOMIC_RELAXED, __HIP_MEMORY_SCOPE_AGENT); }
__device__ __forceinline__ unsigned xb_xcc_id() { return (unsigned)__builtin_amdgcn_s_getreg((3 << 11) | 20) & 0xFu; }
#define XB_SPIN(cond, bar) do { unsigned _sp = 0; while (cond) { __builtin_amdgcn_s_sleep(1); \
    if ((++_sp & 255u) == 0u) { if (xb_ld(&(bar)[XB_TMO])) break; if (_sp > XB_SPIN_CAP) { atomicAdd(&(bar)[XB_TMO], 1u); break; } } } } while (0)
struct XcdBarrier { unsigned* bar; unsigned x; volatile LAS unsigned* st; };
__device__ __forceinline__ XcdBarrier xcd_barrier_post(unsigned* bar, volatile LAS unsigned* st) {
    XcdBarrier b; b.bar = bar; b.x = xb_xcc_id(); b.st = st;
    if (threadIdx.x == 0) (void)xb_add(&bar[XB_XCNT(b.x)], 1u);
    return b;
}
__device__ __forceinline__ void xcd_barrier_complete(unsigned* bar, unsigned x, unsigned& nloc, unsigned& nx) {
    const unsigned G = gridDim.x * gridDim.y * gridDim.z;
    unsigned sum, cnt, mine, sp = 0u;
    for (;;) {
        sum = 0u; cnt = 0u; mine = 0u;
#pragma unroll
        for (unsigned j = 0; j < 16; ++j) { const unsigned c = xb_ld(&bar[XB_XCNT(j)]); sum += c; cnt += (c > 0u) ? 1u : 0u; mine = (j == x) ? c : mine; }
        if (sum == G) break;
        __builtin_amdgcn_s_sleep(1);
        if ((++sp & 255u) == 0u) { if (xb_ld(&bar[XB_TMO])) break; if (sp > XB_SPIN_CAP) { atomicAdd(&bar[XB_TMO], 1u); break; } }
    }
    nloc = mine > 0u ? mine : 1u; nx = cnt > 0u ? cnt : 1u;
}
__device__ __forceinline__ void xcd_barrier(const XcdBarrier& b) {
    asm volatile("s_waitcnt vmcnt(0)" ::: "memory");
    __syncthreads();
    if (threadIdx.x == 0) {
        unsigned* bar = b.bar;
        __builtin_amdgcn_s_waitcnt(0);
        unsigned nloc = b.st[0], nx = b.st[1];
        if (nloc == 0u) { xcd_barrier_complete(bar, b.x, nloc, nx); b.st[0] = nloc; b.st[1] = nx; }
        const unsigned old = xb_add(&bar[XB_XSUB(b.x)], 1u);
        const unsigned gen = old / nloc;
        if (old + 1u == (gen + 1u) * nloc) {
            __builtin_amdgcn_fence(__ATOMIC_RELEASE, "agent");
            asm volatile("s_waitcnt vmcnt(0)" ::: "memory");
            const unsigned og = xb_add(&bar[XB_TOP], 1u);
            const unsigned tg = og / nx;
            if (og + 1u == (tg + 1u) * nx) xb_add(&bar[XB_TOPGEN], 1u);
            else XB_SPIN(xb_ld(&bar[XB_TOPGEN]) == tg, bar);
            __builtin_amdgcn_fence(__ATOMIC_ACQUIRE, "agent");
            xb_add(&bar[XB_XGEN(b.x)], 1u);
            asm volatile("s_waitcnt vmcnt(0)" ::: "memory");
        } else {
            XB_SPIN(xb_ld(&bar[XB_XGEN(b.x)]) == gen, bar);
            __builtin_amdgcn_fence(__ATOMIC_ACQUIRE, "agent");
            asm volatile("s_waitcnt vmcnt(0)" ::: "memory");
        }
    }
    __syncthreads();
}

struct Params {
    const float *x, *c, *ctx, *c_ctx, *w_mod, *b_mod, *norm_mix_w, *w_in, *ret_decay_f, *ret_decay_b, *ret_gn_w, *na_rpb, *w_out, *norm_ffn_w,
                *w_rg, *b_rg, *w_re, *b_re, *w_gate, *w_up, *w_down, *final_norm_w;
    float* out; unsigned char* ws;
};

template <class RowMap>
__device__ __forceinline__ void conv_item(const float* W, int K, int N, bf16_t* WT, LAS float* scr, int kb, int nb, int lane, RowMap rm) {
    const int k0 = 64 * kb, n0 = 32 * nb;
    f32x4 v[8];
#pragma unroll
    for (int i = 0; i < 8; ++i) { const int kk = 8 * i + (lane >> 3); v[i] = __builtin_nontemporal_load((const f32x4*)(W + (size_t)(k0 + kk) * N + n0 + 4 * (lane & 7))); }
#pragma unroll
    for (int i = 0; i < 8; ++i) { const int kk = 8 * i + (lane >> 3); LAS float* d = scr + kk * 33 + 4 * (lane & 7); d[0] = v[i].x; d[1] = v[i].y; d[2] = v[i].z; d[3] = v[i].w; }
    LDS_WAIT(); asm volatile("" ::: "memory");
    const int c = lane & 7;
#pragma unroll
    for (int j = 0; j < 4; ++j) { const int n = (lane >> 3) + 8 * j; const LAS float* s = scr + (8 * c) * 33 + n;
        u32x4 o; o.x = cvt_pk_bf16(s[0 * 33], s[1 * 33]); o.y = cvt_pk_bf16(s[2 * 33], s[3 * 33]); o.z = cvt_pk_bf16(s[4 * 33], s[5 * 33]); o.w = cvt_pk_bf16(s[6 * 33], s[7 * 33]);
        __builtin_nontemporal_store(o, (u32x4*)(WT + (size_t)rm(n0 + n) * K + k0 + 8 * c)); }
    LDS_WAIT(); asm volatile("" ::: "memory");
}
template <class RowMap>
__device__ __forceinline__ void conv_item8(const float* W, int ldo, int N, unsigned char* WT, LAS float* scr, int kb, int nb, int lane, RowMap rm) {
    const int k0 = 64 * kb, n0 = 32 * nb;
    f32x4 v[8];
#pragma unroll
    for (int i = 0; i < 8; ++i) { const int kk = 8 * i + (lane >> 3); v[i] = __builtin_nontemporal_load((const f32x4*)(W + (size_t)(k0 + kk) * N + n0 + 4 * (lane & 7))); }
#pragma unroll
    for (int i = 0; i < 8; ++i) { const int kk = 8 * i + (lane >> 3); LAS float* d = scr + kk * 33 + 4 * (lane & 7); d[0] = v[i].x; d[1] = v[i].y; d[2] = v[i].z; d[3] = v[i].w; }
    LDS_WAIT(); asm volatile("" ::: "memory");
    const int c = lane & 7;
#pragma unroll
    for (int j = 0; j < 4; ++j) { const int n = (lane >> 3) + 8 * j; const LAS float* s = scr + (8 * c) * 33 + n; float h[8];
#pragma unroll
        for (int e = 0; e < 8; ++e) h[e] = s[e * 33] * W8_SCALE;
        __builtin_nontemporal_store(cvt8_fp8(h), (u32x2*)(WT + (size_t)rm(n0 + n) * ldo + k0 + 8 * c)); }
    LDS_WAIT(); asm volatile("" ::: "memory");
}
struct RmIn { __device__ __forceinline__ int operator()(int n) const { const int ct = n >> 8, f = n & 255; if (ct >= 8) return n;
        const int part = f >> 7, rem = f & 127, half = rem >> 6, i = rem & 63; return ct * 256 + half * 128 + part * 64 + i; } };
struct RmId { __device__ __forceinline__ int operator()(int n) const { return n; } };
struct RmGate { __device__ __forceinline__ int operator()(int n) const { return (n >> 7) * 256 + (n & 127); } };
struct RmUp { __device__ __forceinline__ int operator()(int n) const { return (n >> 7) * 256 + 128 + (n & 127); } };
constexpr int NCONV_IN = 7168, NCONV_OUT = 2048, NCONV_E = 16384, NCONV = NCONV_IN + NCONV_OUT + 3 * NCONV_E;
#ifndef SH3
#define SH3 21504
#endif
#ifndef A3
#define A3 30208
#endif
#ifndef A2
#define A2 4608
#endif
#ifndef A5
#define A5 6144
#endif
constexpr int CV_P3 = NCONV_IN, CV_P0 = CV_P3 + A3, CV_P2 = CV_P0 + A2, CV_P9 = CV_P2 + A5;
static_assert(CV_P9 >= NCONV_IN + NCONV_OUT + 2 * NCONV_E && CV_P9 <= NCONV, "gate/up copies must be complete before the gate/up phase");

__device__ __forceinline__ void conv_range(const Params& p, LAS unsigned char* lds, int first, int last, int worker, int nworkers, int wave, int lane) {
    LAS float* scr = (LAS float*)(lds + wave * 8448);
    bf16_t* WinT = (bf16_t*)(p.ws + WS_WIN); bf16_t* WoutT = (bf16_t*)(p.ws + WS_WOUT); unsigned char* WguT = p.ws + WS_WGU; unsigned char* WdT = p.ws + WS_WD;
    for (int it = first + worker; it < last; it += nworkers) {
        int r = it;
        if (r < NCONV_IN) { const int kb = r / 224, nb = r % 224;
            if (nb >= 128) conv_item8(p.w_in, 2 * DM, NIN, (unsigned char*)WinT, scr, kb, nb, lane, RmIn()); else conv_item(p.w_in, DM, NIN, WinT, scr, kb, nb, lane, RmIn()); continue; } r -= NCONV_IN;
        if (r < NCONV_OUT) { conv_item8(p.w_out, 2 * DM, DM, (unsigned char*)WoutT, scr, r / 64, r % 64, lane, RmId()); continue; } r -= NCONV_OUT;
        if (r < NCONV_E) { const int e = r >> 9, r2 = r & 511; conv_item8(p.w_gate + (size_t)e * DM * FF, DM, FF, WguT + (size_t)e * 1024 * DM, scr, r2 >> 4, r2 & 15, lane, RmGate()); continue; } r -= NCONV_E;
        if (r < NCONV_E) { const int e = r >> 9, r2 = r & 511; conv_item8(p.w_up + (size_t)e * DM * FF, DM, FF, WguT + (size_t)e * 1024 * DM, scr, r2 >> 4, r2 & 15, lane, RmUp()); continue; } r -= NCONV_E;
        { const int e = r >> 9, r2 = r & 511; conv_item8(p.w_down + (size_t)e * FF * DM, FF, DM, WdT + (size_t)e * DM * FF, scr, r2 >> 6, r2 & 63, lane, RmId()); }
    }
}
__device__ __forceinline__ void p0_mod_item(const Params& p, LAS unsigned char* lds, int ci, int tid, int wave, int lane) {
    LAS float* sl = (LAS float*)(lds + 69632);
    LAS float* red = (LAS float*)(lds + 69632 + 24576);
    for (int i = tid; i < 3 * 2048; i += 512) { const int r = i >> 11, k = i & 2047; const float v = (r < 2) ? p.c[r * 2048 + k] : p.c_ctx[k]; sl[i] = silu_f(v); }
    __syncthreads();
    const int rr = lane >> 4, cc = (lane & 15) * 4;
    f32x4 a0 = {0.f, 0.f, 0.f, 0.f}, a1 = a0, a2 = a0;
    const float* wp = p.w_mod + (size_t)(256 * wave + rr) * 12288 + 64 * ci + cc;
#pragma unroll 8
    for (int it = 0; it < 64; ++it) { const int k = 256 * wave + 4 * it + rr; const f32x4 wv = __builtin_nontemporal_load((const f32x4*)(wp + (size_t)(4 * it) * 12288));
        a0 += wv * sl[k]; a1 += wv * sl[2048 + k]; a2 += wv * sl[4096 + k]; }
#pragma unroll
    for (int e = 0; e < 4; ++e) { a0[e] = sum_g4(a0[e]); a1[e] = sum_g4(a1[e]); a2[e] = sum_g4(a2[e]); }
    if (lane < 16) {
#pragma unroll
        for (int e = 0; e < 4; ++e) { red[(wave * 3 + 0) * 64 + cc + e] = a0[e]; red[(wave * 3 + 1) * 64 + cc + e] = a1[e]; red[(wave * 3 + 2) * 64 + cc + e] = a2[e]; } }
    __syncthreads();
    if (tid < 192) { const int r = tid >> 6, col = tid & 63; float s = 0.f;
#pragma unroll
        for (int w = 0; w < 8; ++w) s += red[(w * 3 + r) * 64 + col];
        ((float*)(p.ws + WS_MOD))[r * 12288 + 64 * ci + col] = s + p.b_mod[64 * ci + col]; }
    asm volatile("s_waitcnt vmcnt(0)" ::: "memory");
    __syncthreads();
    if (tid == 0) { __builtin_amdgcn_fence(__ATOMIC_RELEASE, "agent"); asm volatile("s_waitcnt vmcnt(0)" ::: "memory");
        __hip_atomic_fetch_add((unsigned*)(p.ws + WS_CTL) + CW_MODRDY, 1u, __ATOMIC_RELAXED, __HIP_MEMORY_SCOPE_AGENT); }
}

__device__ __forceinline__ void p1_rows(const Params& p, int gw, int NGW, int lane) {
    const float* mod = (const float*)(p.ws + WS_MOD); bf16_t* HX = (bf16_t*)(p.ws + WS_HX); unsigned char* HX8 = p.ws + WS_X1;
    for (int row = gw; row < MALL; row += NGW) {
        const float* src = row < MTOK ? p.x + (size_t)row * DM : p.ctx + (size_t)(row - MTOK) * DM;
        const int mr = row < MTOK ? (row >> 12) : 2;
        const f32x4* xr = (const f32x4*)src + lane;
        f32x4 v[8]; float s = 0.f;
#pragma unroll
        for (int j = 0; j < 8; ++j) { v[j] = __builtin_nontemporal_load(xr + 64 * j); s += (v[j].x * v[j].x + v[j].y * v[j].y) + (v[j].z * v[j].z + v[j].w * v[j].w); }
        const float rstd = 1.0f / sqrtf(wave_sum(s) * (1.0f / DM) + NORM_EPS);
        u32x2* o8 = (u32x2*)(HX + (size_t)row * DM) + lane;
#pragma unroll
        for (int j = 0; j < 8; ++j) { const int cidx = 64 * j + lane;
            const f32x4 nw = ((const f32x4*)p.norm_mix_w)[cidx], sh = ((const f32x4*)(mod + mr * 12288))[cidx], sc = ((const f32x4*)(mod + mr * 12288 + 2048))[cidx];
            const f32x4 h = v[j] * rstd * nw * (sc + 1.0f) + sh;
            u32x2 w; w.x = cvt_pk_bf16(h.x, h.y); w.y = cvt_pk_bf16(h.z, h.w); o8[64 * j] = w;
            int q8 = __builtin_amdgcn_cvt_pk_fp8_f32(h.x, h.y, 0, false); q8 = __builtin_amdgcn_cvt_pk_fp8_f32(h.z, h.w, q8, true); *(int*)(HX8 + (size_t)row * (2 * DM) + 4 * cidx) = q8; }
    }
}

struct InProjSched {
    static constexpr bool GATHER = false;
    const char* hx; const char* win; int G, c;
    __device__ __forceinline__ bool next(int i, pg8::Unit& u) const {
        const int L = i * G + c; if (L >= 528) return false;
        int tt, ct, sw;
        if (L < 512) { const int x = L & 7, pos = L >> 3; tt = 4 * x + (pos & 3); const int jb = pos >> 2;
            if (jb < 12) { sw = 0; ct = jb < 8 ? jb : jb + 4; } else { sw = 1; ct = jb - 4; } }
        else { const int r = L - 512; tt = 32 + (r & 1); sw = 1; ct = 4 + (r >> 1); }
        const char* pa = hx + (size_t)tt * (256 * 2048 * 2); const char* pw = win + (size_t)ct * (256 * 2048 * 2);
        u.a = sw ? pw : pa; u.b = sw ? pa : pw; u.i0 = tt; u.i1 = ct; u.i2 = sw; u.i3 = 0; return true;
    }
};
struct InProjSched8 {
    static constexpr bool GATHER = false;
    const char* hx8; const char* win; int NW, w;
    __device__ __forceinline__ bool next(int i, pg8::Unit& u) const {
        if (w < 0) return false;
        const int L = i * NW + w; if (L >= 400) return false;
        int tt, ct, sw;
        if (L < 384) { tt = L & 31; const int jf = L >> 5; if (jf < 8) { sw = 0; ct = 16 + jf; } else { sw = 1; ct = 16 + jf; } }
        else { const int r = L - 384; tt = 32 + (r & 1); const int cj = r >> 1; if (cj < 4) { sw = 0; ct = 20 + cj; } else { sw = 1; ct = 20 + cj; } }
        const char* pa = hx8 + (size_t)tt * (256 * 2048 * 2); const char* pw = win + (size_t)ct * (256 * 2048 * 2);
        u.a = sw ? pw : pa; u.b = sw ? pa : pw; u.i0 = tt; u.i1 = ct; u.i2 = sw; u.i3 = 1; return true;
    }
};
struct EpiInProj {
    static constexpr bool PERM = true, CHAIN = false, AFTER_DRAIN = false;
    unsigned char* ws; const float *decf, *decb;
    __device__ __forceinline__ void store8(bf16_t* dst, const f32x4 v0, const f32x4 v1) const {
        u32x4 w; w.x = cvt_pk_bf16(v0[0], v0[1]); w.y = cvt_pk_bf16(v0[2], v0[3]); w.z = cvt_pk_bf16(v1[0], v1[1]); w.w = cvt_pk_bf16(v1[2], v1[3]); *(u32x4*)dst = w; }
    __device__ __forceinline__ void operator()(const f32x4 (&acc)[2][2][4][2], const pg8::Unit& u, int wr, int wc, int fr, int fq) const {
        asm volatile("" : "+v"(fr), "+v"(fq));
        const int tt = u.i0, ct = u.i1, sw = u.i2, grp = ct >> 2;
        const float ROPE_C = 0.20762050593046014f;
        if (!sw) {
            const int tok0 = 256 * tt + 64 * wr + fr;
            if (grp <= 1) {
                const int h = ct & 3, part = wc >> 1, ibase = 32 * (wc & 1) + 8 * fq;
                const float scale = grp == 1 ? 0.0625f : 1.0f; bf16_t* dst = (bf16_t*)(ws + (grp == 1 ? WS_K : WS_Q));
                const float lgf = log2_sigmoid(decf[h]), lgb = log2_sigmoid(decb[h]);
                const int bb = tt >> 4, uidx = (bb * 4 + h) * 16 + (tt & 15);
                bf16_t* QP = (bf16_t*)(ws + WS_QP) + (size_t)uidx * 256 * 768;
                bf16_t* kTf = (bf16_t*)(ws + WS_KTF) + (size_t)(bb * 4 + h) * 256 * LDT + 256 + 256 * (tt & 15); bf16_t* kTb = (bf16_t*)(ws + WS_KTB) + (size_t)(bb * 4 + h) * 256 * LDT + 256 + 256 * (tt & 15);
                float inv[2][4];
#pragma unroll
                for (int n = 0; n < 2; ++n)
#pragma unroll
                    for (int e = 0; e < 4; ++e) inv[n][e] = exp2f(-(float)(ibase + 4 * n + e) * ROPE_C);
#pragma unroll
                for (int ai = 0; ai < 2; ++ai)
#pragma unroll
                    for (int m = 0; m < 4; ++m) { const int pl = 128 * ai + 64 * wr + 16 * m + fr, tok = 256 * tt + pl, ntok = tok & 4095; const float pos = (float)(part ? (ntok & 63) : (ntok >> 6));
                        f32x4 o1[2], o2[2];
#pragma unroll
                        for (int n = 0; n < 2; ++n)
#pragma unroll
                            for (int e = 0; e < 4; ++e) { float sn, cs; sincos_ang(pos * inv[n][e], sn, cs); const float x1 = acc[ai][0][m][n][e], x2 = acc[ai][1][m][n][e];
                                o1[n][e] = (x1 * cs - x2 * sn) * scale; o2[n][e] = (x1 * sn + x2 * cs) * scale; }
                        bf16_t* rowp = dst + (size_t)tok * 1024 + h * 256 + part * 128 + ibase;
                        store8(rowp, o1[0], o1[1]); store8(rowp + 64, o2[0], o2[1]);
                        if (grp == 0) {
                            const float rf = exp2f(lgf * (float)(pl + 1)), rb = exp2f(lgb * (float)(256 - pl));
                            bf16_t* qrow = QP + (size_t)pl * 768 + part * 128 + ibase;
                            store8(qrow, o1[0] * rf, o1[1] * rf); store8(qrow + 64, o2[0] * rf, o2[1] * rf);
                            store8(qrow + 256, o1[0] * rb, o1[1] * rb); store8(qrow + 256 + 64, o2[0] * rb, o2[1] * rb);
                        } else {
                            const float dfr = exp2f(lgf * (float)(255 - pl)), dbr = exp2f(lgb * (float)pl);
#pragma unroll
                            for (int n = 0; n < 2; ++n)
#pragma unroll
                                for (int e = 0; e < 4; ++e) { const int f1 = part * 128 + ibase + 4 * n + e;
                                    const unsigned w1 = cvt_pk_bf16(o1[n][e] * dfr, o1[n][e] * dbr), w2 = cvt_pk_bf16(o2[n][e] * dfr, o2[n][e] * dbr);
                                    kTf[(size_t)f1 * LDT + pl] = (bf16_t)(w1 & 0xffffu); kTb[(size_t)f1 * LDT + pl] = (bf16_t)(w1 >> 16);
                                    kTf[(size_t)(f1 + 64) * LDT + pl] = (bf16_t)(w2 & 0xffffu); kTb[(size_t)(f1 + 64) * LDT + pl] = (bf16_t)(w2 >> 16); }
                        }
                        __builtin_amdgcn_sched_barrier(0); }
            } else {
                bf16_t* dst = (bf16_t*)(ws + (grp == 3 ? WS_G : (grp == 4 ? WS_NQ : WS_NK))); const int cb = (ct & 3) * 256 + 32 * wc + 8 * fq;
                const float s8 = (grp == 4 ? 0.08838834764831845f : 1.0f) * (u.i3 ? 1.0f / W8_SCALE : 1.0f);
#pragma unroll
                for (int ai = 0; ai < 2; ++ai)
#pragma unroll
                    for (int m = 0; m < 4; ++m) { const int tok = tok0 + 128 * ai + 16 * m;
#pragma unroll
                        for (int bj = 0; bj < 2; ++bj) { f32x4 v0 = acc[ai][bj][m][0], v1 = acc[ai][bj][m][1];
                            if (grp == 3) {
#pragma unroll
                                for (int e = 0; e < 4; ++e) { v0[e] = silu_f(v0[e]); v1[e] = silu_f(v1[e]); } }
                            else { v0 = v0 * s8; v1 = v1 * s8; }
                            store8(dst + (size_t)tok * 1024 + cb + 128 * bj, v0, v1); } __builtin_amdgcn_sched_barrier(0); }
            }
        } else {
            const bool isctx = tt >= 32; const int b = isctx ? tt - 32 : (tt >> 4);
            const int tcol0 = 32 * wc + 8 * fq;
            const int colbase = isctx ? 0 : 256 + 256 * (tt & 15);
            if (grp == 1) {
                bf16_t* kTf = (bf16_t*)(ws + WS_KTF); bf16_t* kTb = (bf16_t*)(ws + WS_KTB);
                const int h = ct & 3, part = wr; const float lgf = log2_sigmoid(decf[h]), lgb = log2_sigmoid(decb[h]);
                float inv[4];
#pragma unroll
                for (int m = 0; m < 4; ++m) inv[m] = exp2f(-(float)(16 * m + fr) * ROPE_C);
#pragma unroll
                for (int bj = 0; bj < 2; ++bj) {
                    float df[2][4], db[2][4], pos[2][4];
#pragma unroll
                    for (int n = 0; n < 2; ++n)
#pragma unroll
                        for (int e = 0; e < 4; ++e) { const int tcol = 128 * bj + tcol0 + 4 * n + e; df[n][e] = exp2f(lgf * (float)(255 - tcol)) * 0.0625f; db[n][e] = exp2f(lgb * (float)tcol) * 0.0625f;
                            pos[n][e] = (float)(part ? (tcol & 63) : (4 * (tt & 15) + (tcol >> 6))); }
#pragma unroll
                    for (int m = 0; m < 4; ++m) { const int i = 16 * m + fr, f1 = part * 128 + i;
                        f32x4 o1[2], o2[2];
#pragma unroll
                        for (int n = 0; n < 2; ++n)
#pragma unroll
                            for (int e = 0; e < 4; ++e) { const float x1 = acc[0][bj][m][n][e], x2 = acc[1][bj][m][n][e]; float y1 = x1, y2 = x2;
                                if (!isctx) { float sn, cs; sincos_ang(pos[n][e] * inv[m], sn, cs); y1 = x1 * cs - x2 * sn; y2 = x1 * sn + x2 * cs; }
                                o1[n][e] = y1; o2[n][e] = y2; }
                        const size_t r1 = ((size_t)(b * 4 + h) * 256 + f1) * LDT + colbase + 128 * bj + tcol0, r2 = r1 + (size_t)64 * LDT;
                        { f32x4 t0, t1; for (int e = 0; e < 4; ++e) { t0[e] = o1[0][e] * df[0][e]; t1[e] = o1[1][e] * df[1][e]; } store8(kTf + r1, t0, t1); }
                        __builtin_amdgcn_sched_barrier(0);
                        { f32x4 t0, t1; for (int e = 0; e < 4; ++e) { t0[e] = o2[0][e] * df[0][e]; t1[e] = o2[1][e] * df[1][e]; } store8(kTf + r2, t0, t1); }
                        __builtin_amdgcn_sched_barrier(0);
                        { f32x4 t0, t1; for (int e = 0; e < 4; ++e) { t0[e] = o1[0][e] * db[0][e]; t1[e] = o1[1][e] * db[1][e]; } store8(kTb + r1, t0, t1); }
                        __builtin_amdgcn_sched_barrier(0);
                        { f32x4 t0, t1; for (int e = 0; e < 4; ++e) { t0[e] = o2[0][e] * db[0][e]; t1[e] = o2[1][e] * db[1][e]; } store8(kTb + r2, t0, t1); }
                        __builtin_amdgcn_sched_barrier(0); }
                }
            } else {
#pragma unroll
                for (int ai = 0; ai < 2; ++ai)
#pragma unroll
                    for (int m = 0; m < 4; ++m) { const int pr = 128 * ai + 64 * wr + 16 * m + fr;
                        bf16_t* rowp = (bf16_t*)(ws + WS_NVT) + ((size_t)(b * 8 + 2 * (ct & 3) + ai) * 128 + (pr & 127)) * LDT + colbase;
                        if (grp == 2) rowp = isctx ? (bf16_t*)(ws + WS_SVC) + ((size_t)(b * 4 + (ct & 3)) * 256 + pr) * 768 + 512 : (bf16_t*)(ws + WS_SV) + ((size_t)((b * 4 + (ct & 3)) * 16 + (tt & 15)) * 256 + pr) * 768 + 512;
#pragma unroll
                        for (int bj = 0; bj < 2; ++bj) { const float s8 = u.i3 ? 1.0f / W8_SCALE : 1.0f; store8(rowp + 128 * bj + tcol0, acc[ai][bj][m][0] * s8, acc[ai][bj][m][1] * s8); } __builtin_amdgcn_sched_barrier(0); }
            }
        }
    }
};

struct ChainSched {
    static constexpr bool GATHER = false;
    const char* sv; const char* svc; const char* kT; int dir;
    __device__ __forceinline__ bool next(int i, pg8::Unit& u) const {
        if (i >= 16) return false;
        const int c = dir == 0 ? i - 1 : 16 - i;
        u.a = (i == 0) ? svc : sv + (size_t)c * (256 * 768 * 2); u.b = kT + (size_t)((i == 0) ? 0 : 256 + 256 * c) * 2;
        u.i0 = dir == 0 ? i : 15 - i; u.i1 = 0; u.i2 = 0; u.i3 = 0; return true;
    }
};
struct EpiChain {
    static constexpr bool PERM = true, CHAIN = true, AFTER_DRAIN = false;
    bf16_t* SVbh; int dir; float cdec;
    __device__ __forceinline__ float chain_scale(const pg8::Unit&) const { return cdec; }
    __device__ __forceinline__ void operator()(const f32x4 (&acc)[2][2][4][2], const pg8::Unit& u, int wr, int wc, int fr, int fq) const {
        asm volatile("" : "+v"(fr), "+v"(fq));
        bf16_t* base = SVbh + (size_t)u.i0 * (256 * 768) + dir * 256;
        constexpr int ai = 0;
#pragma unroll
            for (int m = 0; m < 4; ++m) { bf16_t* rowp = base + (size_t)(64 * wr + 16 * m + fr) * 768 + 32 * wc + 8 * fq;
#pragma unroll
                for (int bj = 0; bj < 2; ++bj) { const f32x4 v0 = acc[ai][bj][m][0], v1 = acc[ai][bj][m][1];
                    u32x4 w; w.x = cvt_pk_bf16(v0[0], v0[1]); w.y = cvt_pk_bf16(v0[2], v0[3]); w.z = cvt_pk_bf16(v1[0], v1[1]); w.w = cvt_pk_bf16(v1[2], v1[3]); *(u32x4*)(rowp + 128 * bj) = w; } }
    }
};
struct ScoreSched {
    static constexpr bool GATHER = false;
    const char* q; const char* k; int unit;
    __device__ __forceinline__ bool next(int i, pg8::Unit& u) const {
        if (i > 0 || unit < 0) return false;
        const int c = unit & 15, h = (unit >> 4) & 3, b = unit >> 6; const size_t off = ((size_t)(b * 4096 + 256 * c) * 1024 + h * 256) * 2;
        u.a = q + off; u.b = k + off; u.i0 = unit; u.i1 = h; u.i2 = 0; u.i3 = 0; return true;
    }
};
struct EpiScore {
    static constexpr bool PERM = true, CHAIN = false, AFTER_DRAIN = false;
    bf16_t* QP; const float *decf, *decb;
    __device__ __forceinline__ void operator()(const f32x4 (&acc)[2][2][4][2], const pg8::Unit& u, int wr, int wc, int fr, int fq) const {
        asm volatile("" : "+v"(fr), "+v"(fq));
        const float lgf = log2_sigmoid(decf[u.i1]), lgb = log2_sigmoid(decb[u.i1]);
        bf16_t* base = QP + (size_t)u.i0 * (256 * 768) + 512;
#pragma unroll
        for (int ai = 0; ai < 2; ++ai)
#pragma unroll
            for (int m = 0; m < 4; ++m) { const int i = 128 * ai + 64 * wr + 16 * m + fr;
#pragma unroll
                for (int bj = 0; bj < 2; ++bj) { const int j0 = 128 * bj + 32 * wc + 8 * fq; f32x4 v[2];
#pragma unroll
                    for (int n = 0; n < 2; ++n)
#pragma unroll
                        for (int e = 0; e < 4; ++e) { const int d = i - (j0 + 4 * n + e); const float D = d > 0 ? exp2f(lgf * (float)d) : (d < 0 ? exp2f(lgb * (float)(-d)) : 2.0f); v[n][e] = acc[ai][bj][m][n][e] * D; }
                    u32x4 w; w.x = cvt_pk_bf16(v[0][0], v[0][1]); w.y = cvt_pk_bf16(v[0][2], v[0][3]); w.z = cvt_pk_bf16(v[1][0], v[1][1]); w.w = cvt_pk_bf16(v[1][2], v[1][3]);
                    *(u32x4*)(base + (size_t)i * 768 + j0) = w; }
                __builtin_amdgcn_sched_barrier(0); }
    }
};
struct RetOutSched {
    static constexpr bool GATHER = false;
    const char* qp; const char* sv; int unit;
    __device__ __forceinline__ bool next(int i, pg8::Unit& u) const {
        if (i > 0 || unit < 0) return false;
        u.a = qp + (size_t)unit * (256 * 768 * 2); u.b = sv + (size_t)unit * (256 * 768 * 2); u.i0 = unit; u.i1 = 0; u.i2 = 0; u.i3 = 0; return true;
    }
};
struct EpiRetOut {
    static constexpr bool PERM = true, CHAIN = false, AFTER_DRAIN = true;
    const bf16_t* G; const float* gnw; bf16_t* MIX;
    __device__ __forceinline__ void operator()(const f32x4 (&)[2][2][4][2], const pg8::Unit&, int, int, int, int) const {}
    __device__ __forceinline__ void fused(const f32x4 (&acc)[2][2][4][2], const pg8::Unit& u, int wr, int wc, int fr, int fq, LAS unsigned char* lds) const {
        asm volatile("" : "+v"(fr), "+v"(fq));
        const int unit = u.i0, c = unit & 15, h = (unit >> 4) & 3, b = unit >> 6;
        LAS f32x2* Pst = (LAS f32x2*)lds;
#pragma unroll
        for (int ai = 0; ai < 2; ++ai)
#pragma unroll
            for (int m = 0; m < 4; ++m) { float s = 0.f, q = 0.f;
#pragma unroll
                for (int bj = 0; bj < 2; ++bj)
#pragma unroll
                    for (int n = 0; n < 2; ++n) { const f32x4 x = acc[ai][bj][m][n]; s += (x[0] + x[1]) + (x[2] + x[3]); q += (x[0] * x[0] + x[1] * x[1]) + (x[2] * x[2] + x[3] * x[3]); }
                s = sum_g4(s); q = sum_g4(q);
                if (fq == 0) Pst[(128 * ai + 64 * wr + 16 * m + fr) * 4 + wc] = (f32x2){s, q}; }
        asm volatile("s_waitcnt lgkmcnt(0)" ::: "memory"); __builtin_amdgcn_s_barrier(); asm volatile("" ::: "memory");
        f32x4 gw0[2], gw1[2];
#pragma unroll
        for (int bj = 0; bj < 2; ++bj) { const int v0 = h * 256 + 128 * bj + 32 * wc + 8 * fq; gw0[bj] = *(const f32x4*)(gnw + v0); gw1[bj] = *(const f32x4*)(gnw + v0 + 4); }
#pragma unroll
        for (int ai = 0; ai < 2; ++ai) {
            u32x4 gg[4][2];
#pragma unroll
            for (int m = 0; m < 4; ++m) { const size_t tok = (size_t)b * 4096 + 256 * c + 128 * ai + 64 * wr + 16 * m + fr;
#pragma unroll
                for (int bj = 0; bj < 2; ++bj) gg[m][bj] = *(const u32x4*)(G + tok * 1024 + h * 256 + 128 * bj + 32 * wc + 8 * fq); }
#pragma unroll
            for (int m = 0; m < 4; ++m) { const int r = 128 * ai + 64 * wr + 16 * m + fr;
                const f32x2 p0 = Pst[r * 4 + 0], p1 = Pst[r * 4 + 1], p2 = Pst[r * 4 + 2], p3 = Pst[r * 4 + 3];
                const float mu = ((p0.x + p1.x) + (p2.x + p3.x)) * (1.0f / 256.0f); const float ex2 = ((p0.y + p1.y) + (p2.y + p3.y)) * (1.0f / 256.0f);
                const float rstd = 1.0f / sqrtf(fmaxf(ex2 - mu * mu, 0.f) + NORM_EPS);
                const size_t tok = (size_t)b * 4096 + 256 * c + r;
#pragma unroll
                for (int bj = 0; bj < 2; ++bj) { const int v0 = h * 256 + 128 * bj + 32 * wc + 8 * fq; const u32x4 g4 = gg[m][bj];
                    const f32x4 y0 = (acc[ai][bj][m][0] - mu) * rstd * gw0[bj], y1 = (acc[ai][bj][m][1] - mu) * rstd * gw1[bj];
                    float h8[8] = {y0[0] * bflo(g4.x) * MIX8_SCALE, y0[1] * bfhi(g4.x) * MIX8_SCALE, y0[2] * bflo(g4.y) * MIX8_SCALE, y0[3] * bfhi(g4.y) * MIX8_SCALE,
                                   y1[0] * bflo(g4.z) * MIX8_SCALE, y1[1] * bfhi(g4.z) * MIX8_SCALE, y1[2] * bflo(g4.w) * MIX8_SCALE, y1[3] * bfhi(g4.w) * MIX8_SCALE};
                    *(u32x2*)((unsigned char*)MIX + tok * 4096 + v0) = cvt8_fp8(h8); } }
        }
    }
};

__device__ __forceinline__ bf16x8 pack8(const f32x4 a, const f32x4 b) {
    u32x4 w; w.x = cvt_pk_bf16(a[0], a[1]); w.y = cvt_pk_bf16(a[2], a[3]); w.z = cvt_pk_bf16(b[0], b[1]); w.w = cvt_pk_bf16(b[2], b[3]); return __builtin_bit_cast(bf16x8, w); }
__device__ __forceinline__ bf16x8 ld44(const bf16_t* p0) { const s16x4 lo = *(const s16x4*)p0, hi = *(const s16x4*)(p0 + 16); bf16x8 r; r[0] = lo[0]; r[1] = lo[1]; r[2] = lo[2]; r[3] = lo[3]; r[4] = hi[0]; r[5] = hi[1]; r[6] = hi[2]; r[7] = hi[3]; return r; }

__device__ __forceinline__ void na_item(const Params& p, int it, int lane) {
    asm volatile("" : "+v"(lane));
    const bf16_t* NQ = (const bf16_t*)(p.ws + WS_NQ); const bf16_t* NK = (const bf16_t*)(p.ws + WS_NK); const bf16_t* NVT = (const bf16_t*)(p.ws + WS_NVT); bf16_t* MIX = (bf16_t*)(p.ws + WS_MIX);
    const int qb = it & 3, r = (it >> 2) & 63, nh = (it >> 8) & 7, b = it >> 11;
    const int l15 = lane & 15, g = lane >> 4;
    const int rs = min(max(r - 4, 0), 56), c0 = min(max(16 * qb - 8, 0), 32);
    const int qc = 16 * qb + l15; const size_t tq = (size_t)b * 4096 + r * 64 + qc;
    bf16x8 bq[4];
#pragma unroll
    for (int ks = 0; ks < 4; ++ks) bq[ks] = *(const bf16x8*)(NQ + tq * 1024 + nh * 128 + 32 * ks + 8 * g);
    f32x4 s[32];
#pragma unroll
    for (int f = 0; f < 32; ++f) {
        size_t kt;
        if (f < 16) kt = (size_t)b * 4096 + (rs + (f >> 1)) * 64 + c0 + 16 * (f & 1) + l15; else kt = (size_t)MTOK + b * 256 + 16 * (f - 16) + l15;
        const bf16_t* kp = NK + kt * 1024 + nh * 128 + 8 * g;
        f32x4 a = {0.f, 0.f, 0.f, 0.f};
#pragma unroll
        for (int ks = 0; ks < 4; ++ks) a = __builtin_amdgcn_mfma_f32_16x16x32_bf16(*(const bf16x8*)(kp + 32 * ks), bq[ks], a, 0, 0, 0);
        s[f] = a;
    }
    const int cs = min(max(qc - 8, 0), 48);
    const float* rp = p.na_rpb + nh * 15 * 31;
    float mx = -1e30f;
#pragma unroll
    for (int f = 0; f < 16; ++f) { const int kr = f >> 1; const float* rrow = rp + (rs + kr - r + 7) * 31;
#pragma unroll
        for (int j = 0; j < 4; ++j) { const int kc = c0 + 16 * (f & 1) + 4 * g + j; const bool valid = (kc >= cs) && (kc < cs + 16);
            float v = -1e30f; if (valid) v = s[f][j] + rrow[kc - qc + 15]; s[f][j] = v; mx = fmaxf(mx, v); } }
#pragma unroll
    for (int f = 16; f < 32; ++f)
#pragma unroll
        for (int j = 0; j < 4; ++j) mx = fmaxf(mx, s[f][j]);
    mx = max_g4(mx);
    float l = 0.f;
#pragma unroll
    for (int f = 0; f < 32; ++f)
#pragma unroll
        for (int j = 0; j < 4; ++j) { const float v = s[f][j]; const float e = (v <= -1e29f) ? 0.f : exp2f((v - mx) * LOG2E); s[f][j] = e; l += e; }
    l = sum_g4(l);
    f32x4 o[8];
#pragma unroll
    for (int df = 0; df < 8; ++df) o[df] = (f32x4){0.f, 0.f, 0.f, 0.f};
#pragma unroll
    for (int t = 0; t < 16; ++t) {
        const bf16x8 pb = pack8(s[2 * t], s[2 * t + 1]);
        const int col = (t < 8) ? 256 + (rs + t) * 64 + c0 + 4 * g : 32 * (t - 8) + 4 * g;
#pragma unroll
        for (int df = 0; df < 8; ++df) { const bf16_t* vp = NVT + ((size_t)(b * 8 + nh) * 128 + 16 * df + l15) * LDT + col;
            o[df] = __builtin_amdgcn_mfma_f32_16x16x32_bf16(ld44(vp), pb, o[df], 0, 0, 0); }
    }
    const float inv = 1.0f / l;
#pragma unroll
    for (int df = 0; df < 8; ++df) { u32x2 w; w.x = cvt_pk_bf16(o[df][0] * inv, o[df][1] * inv); w.y = cvt_pk_bf16(o[df][2] * inv, o[df][3] * inv);
        *(u32x2*)(MIX + tq * 2048 + 1024 + nh * 128 + 16 * df + 4 * g) = w; }
}


__device__ __forceinline__ void na_wg_item(const Params& p, LAS unsigned char* lds, int item, int wave, int lane) {
    asm volatile("" : "+v"(lane));
    const bf16_t* NQ = (const bf16_t*)(p.ws + WS_NQ); const bf16_t* NK = (const bf16_t*)(p.ws + WS_NK); const bf16_t* NVT = (const bf16_t*)(p.ws + WS_NVT); bf16_t* MIX = (bf16_t*)(p.ws + WS_MIX);
    const int r = item & 63, nh = (item >> 6) & 7, b = item >> 9;
    const int tid = wave * 64 + lane, l15 = lane & 15, g = lane >> 4, qb = wave & 3, half = wave >> 2;
    const int rs = min(max(r - 4, 0), 56), c0 = min(max(16 * qb - 8, 0), 32);
    const int qc = 16 * qb + l15; const size_t tq = (size_t)b * 4096 + r * 64 + qc;
    LAS float* mxs = (LAS float*)(lds + 148480);
    LAS float* sms = mxs + 128;
    LAS float* rpbs = (LAS float*)(lds + 150528);
    LAS unsigned char* xo = lds + 98304;
    const bf16_t* nvrow = NVT + (size_t)(b * 8 + nh) * 128 * LDT;
#define NA_DMAK(s, buf) do { _Pragma("unroll") for (int i = 0; i < 6; ++i) { const int q = wave + 8 * i, row = 4 * q + (lane >> 4), c = (lane & 15) ^ (row & 15); \
        const size_t trow = (i < 4) ? (size_t)b * 4096 + (rs + 2 * (s) + (row >> 6)) * 64 + (row & 63) : (size_t)MTOK + b * 256 + 64 * (s) + (row - 128); \
        __builtin_amdgcn_global_load_lds((const unsigned*)(NK + trow * 1024 + nh * 128 + 8 * c), (LAS unsigned*)((buf) + q * 1024), 16, 0, 0); } } while (0)
#define NA_DMAV(s, buf) do { _Pragma("unroll") for (int i = 0; i < 6; ++i) { \
        if (i < 4) { const int q = wave + 8 * i, d = 4 * q + (lane >> 4), c = (lane & 15) ^ (d & 15); \
            __builtin_amdgcn_global_load_lds((const unsigned*)(nvrow + (size_t)d * LDT + 256 + (rs + 2 * (s)) * 64 + 8 * c), (LAS unsigned*)((buf) + q * 1024), 16, 0, 0); } \
        else { const int q2 = wave + 8 * (i - 4), d = 8 * q2 + (lane >> 3), c = (lane & 7) ^ (d & 7); \
            __builtin_amdgcn_global_load_lds((const unsigned*)(nvrow + (size_t)d * LDT + 64 * (s) + 8 * c), (LAS unsigned*)((buf) + 32768 + q2 * 1024), 16, 0, 0); } } } while (0)
#define NA_BUF(gst) (lds + ((gst) % 3) * 49152)
#define NA_SYNC(n) do { asm volatile("s_waitcnt vmcnt(" #n ") lgkmcnt(0)" ::: "memory"); __builtin_amdgcn_s_barrier(); asm volatile("" ::: "memory"); } while (0)
    f32x4 sf[16];
    NA_DMAK(0, NA_BUF(0));
    bf16x8 bq[4];
#pragma unroll
    for (int ks = 0; ks < 4; ++ks) bq[ks] = *(const bf16x8*)(NQ + tq * 1024 + nh * 128 + 32 * ks + 8 * g);
    float rpbv = 0.f; if (tid < 465) rpbv = p.na_rpb[nh * 465 + tid];
    NA_DMAK(1, NA_BUF(1));
    asm volatile("s_waitcnt vmcnt(6)" : "+v"(rpbv), "+v"(bq[0]), "+v"(bq[1]), "+v"(bq[2]), "+v"(bq[3]) :: "memory");
    if (tid < 465) rpbs[tid] = rpbv;
    NA_SYNC(6);
#pragma unroll
    for (int s = 0; s < 4; ++s) {
        LAS unsigned char* cur = NA_BUF(s);
        if (s == 0) NA_DMAK(2, NA_BUF(2)); else if (s == 1) NA_DMAK(3, NA_BUF(3)); else if (s == 2) NA_DMAV(0, NA_BUF(4)); else NA_DMAV(1, NA_BUF(5));
#pragma unroll
        for (int fi = 0; fi < 4; ++fi) { const int row = half ? 128 + 16 * fi + l15 : (fi >> 1) * 64 + c0 + 16 * (fi & 1) + l15;
            f32x4 a = {0.f, 0.f, 0.f, 0.f};
#pragma unroll
            for (int ks = 0; ks < 4; ++ks) a = __builtin_amdgcn_mfma_f32_16x16x32_bf16(*(const LAS bf16x8*)(cur + row * 256 + (((4 * ks + g) ^ (row & 15)) << 4)), bq[ks], a, 0, 0, 0);
            sf[4 * s + fi] = a; }
        NA_SYNC(6);
    }
    float mx = -1e30f;
    if (!half) {
        const int cs = min(max(qc - 8, 0), 48);
#pragma unroll
        for (int f = 0; f < 16; ++f) { const int kr = f >> 1; const LAS float* rrow = rpbs + (rs + kr - r + 7) * 31 - qc + 15;
#pragma unroll
            for (int j = 0; j < 4; ++j) { const int kc = c0 + 16 * (f & 1) + 4 * g + j; const bool valid = (kc >= cs) && (kc < cs + 16);
                float v = -1e30f; if (valid) v = sf[f][j] + rrow[kc]; sf[f][j] = v; mx = fmaxf(mx, v); } }
    } else {
#pragma unroll
        for (int f = 0; f < 16; ++f)
#pragma unroll
            for (int j = 0; j < 4; ++j) mx = fmaxf(mx, sf[f][j]);
    }
    mx = max_g4(mx);
    if (g == 0) mxs[half * 64 + qc] = mx;
    NA_SYNC(6);
    mx = fmaxf(mxs[qc], mxs[64 + qc]) * LOG2E;
    float l = 0.f;
#pragma unroll
    for (int f = 0; f < 16; ++f)
#pragma unroll
        for (int j = 0; j < 4; ++j) { const float v = sf[f][j]; const float e = (v <= -1e29f) ? 0.f : __builtin_amdgcn_exp2f(v * LOG2E - mx); sf[f][j] = e; l += e; }
    l = sum_g4(l);
    if (g == 0) sms[half * 64 + qc] = l;
    bf16x8 pb[8];
#pragma unroll
    for (int t = 0; t < 8; ++t) pb[t] = pack8(sf[2 * t], sf[2 * t + 1]);
    f32x4 o[8];
#pragma unroll
    for (int df = 0; df < 8; ++df) o[df] = (f32x4){0.f, 0.f, 0.f, 0.f};
    const int vbase = half ? 32768 : 0, vstride = half ? 128 : 256, vsw = l15 & (half ? 7 : 15);
#pragma unroll
    for (int s = 0; s < 4; ++s) {
        LAS unsigned char* cur = NA_BUF(s + 4);
        if (s == 0) NA_DMAV(2, NA_BUF(6)); else if (s == 1) NA_DMAV(3, NA_BUF(7));
#pragma unroll
        for (int k2 = 0; k2 < 2; ++k2) { const int ch0 = (half ? 4 * k2 : 8 * k2 + (c0 >> 3)) + (g >> 1);
#pragma unroll
            for (int df = 0; df < 8; ++df) { const LAS unsigned char* rowp = cur + vbase + (16 * df + l15) * vstride + 8 * (g & 1);
                const s16x4 lo = *(const LAS s16x4*)(rowp + ((ch0 ^ vsw) << 4)), hi = *(const LAS s16x4*)(rowp + (((ch0 + 2) ^ vsw) << 4));
                bf16x8 a; a[0] = lo[0]; a[1] = lo[1]; a[2] = lo[2]; a[3] = lo[3]; a[4] = hi[0]; a[5] = hi[1]; a[6] = hi[2]; a[7] = hi[3];
                o[df] = __builtin_amdgcn_mfma_f32_16x16x32_bf16(a, pb[2 * s + k2], o[df], 0, 0, 0); } }
        if (s == 3 && half) {
#pragma unroll
            for (int df = 0; df < 8; ++df) *(LAS f32x4*)(xo + ((qb * 8 + df) * 64 + lane) * 16) = o[df]; }
        if (s < 2) NA_SYNC(6); else NA_SYNC(0);
    }
    if (!half) {
        const float inv = 1.0f / (sms[qc] + sms[64 + qc]);
#pragma unroll
        for (int df = 0; df < 8; ++df) { const f32x4 oc = *(const LAS f32x4*)(xo + ((qb * 8 + df) * 64 + lane) * 16); const f32x4 t = (o[df] + oc) * (inv * MIX8_SCALE);
            int q8 = __builtin_amdgcn_cvt_pk_fp8_f32(t[0], t[1], 0, false); q8 = __builtin_amdgcn_cvt_pk_fp8_f32(t[2], t[3], q8, true);
            *(int*)((unsigned char*)MIX + tq * 4096 + 1024 + nh * 128 + 16 * df + 4 * g) = q8; }
    }
    NA_SYNC(0);
#undef NA_BUF
#undef NA_DMAK
#undef NA_DMAV
#undef NA_SYNC
}

struct OutProjSched {
    static constexpr bool GATHER = false;
    const char* mix; const char* wout; int G, c;
    __device__ __forceinline__ bool next(int i, pg8::Unit& u) const {
        const int L = i * G + c; if (L >= 256) return false;
        const int x = L & 7, pos = L >> 3, tt = 4 * x + (pos & 3), nt = pos >> 2;
        u.a = mix + (size_t)tt * (256 * 2048 * 2); u.b = wout + (size_t)nt * (256 * 2048 * 2); u.i0 = tt; u.i1 = nt; u.i2 = 0; u.i3 = 0; return true;
    }
};
struct EpiOutProj {
    static constexpr bool PERM = true, CHAIN = false, AFTER_DRAIN = false;
    const float* x; const float* mod; bf16_t* x1;
    __device__ __forceinline__ void operator()(const f32x4 (&acc)[2][2][4][2], const pg8::Unit& u, int wr, int wc, int fr, int fq) const {
        asm volatile("" : "+v"(fr), "+v"(fq));
        const int tt = u.i0, b = tt >> 4; const int col0 = 256 * u.i1 + 32 * wc + 8 * fq;
        const float* ga = mod + b * 12288 + 2 * 2048;
        f32x4 gv[2][2];
#pragma unroll
        for (int bj = 0; bj < 2; ++bj) { gv[bj][0] = *(const f32x4*)(ga + col0 + 128 * bj) * (1.0f / (W8_SCALE * MIX8_SCALE)); gv[bj][1] = *(const f32x4*)(ga + col0 + 128 * bj + 4) * (1.0f / (W8_SCALE * MIX8_SCALE)); }
#pragma unroll
        for (int am = 0; am < 4; ++am) { const int ai = am >> 1, mb = 2 * (am & 1);
            f32x4 xv[2][2][2];
#pragma unroll
            for (int m = 0; m < 2; ++m) { const size_t off = (size_t)(256 * tt + 128 * ai + 64 * wr + 16 * (mb + m) + fr) * DM + col0;
#pragma unroll
                for (int bj = 0; bj < 2; ++bj) { xv[m][bj][0] = __builtin_nontemporal_load((const f32x4*)(x + off + 128 * bj)); xv[m][bj][1] = __builtin_nontemporal_load((const f32x4*)(x + off + 128 * bj + 4)); } }
#pragma unroll
            for (int m = 0; m < 2; ++m) { const size_t off = (size_t)(256 * tt + 128 * ai + 64 * wr + 16 * (mb + m) + fr) * DM + col0;
#pragma unroll
                for (int bj = 0; bj < 2; ++bj) { const f32x4 r0 = xv[m][bj][0] + gv[bj][0] * acc[ai][bj][mb + m][0], r1 = xv[m][bj][1] + gv[bj][1] * acc[ai][bj][mb + m][1];
                    u32x4 w; w.x = cvt_pk_bf16(r0[0], r0[1]); w.y = cvt_pk_bf16(r0[2], r0[3]); w.z = cvt_pk_bf16(r1[0], r1[1]); w.w = cvt_pk_bf16(r1[2], r1[3]);
                    *(u32x4*)(x1 + off + 128 * bj) = w; } }
        }
    }
};

constexpr int P7_LD = 2050;
__device__ __forceinline__ void p7_item(const Params& p, LAS unsigned char* lds, int item, int slot, int tid, int wave, int lane) {
    const float* mod = (const float*)(p.ws + WS_MOD); const bf16_t* X1 = (const bf16_t*)(p.ws + WS_X1); unsigned char* HF = p.ws + WS_HF;
    LAS float* hfs = (LAS float*)lds;
    LAS float* red = (LAS float*)(lds + 131584);
    const int row0 = item * 16;
    {
        u32x4 raw[2][4];
#pragma unroll
        for (int rr = 0; rr < 2; ++rr)
#pragma unroll
            for (int j = 0; j < 4; ++j) raw[rr][j] = ((const u32x4*)(X1 + (size_t)(row0 + 2 * wave + rr) * DM))[64 * j + lane];
#pragma unroll
        for (int rr = 0; rr < 2; ++rr) {
            const int li = 2 * wave + rr, row = row0 + li, b = row >> 12;
            float v[4][8]; float s = 0.f;
#pragma unroll
            for (int j = 0; j < 4; ++j) { const u32x4 w = raw[rr][j];
                v[j][0] = bflo(w.x); v[j][1] = bfhi(w.x); v[j][2] = bflo(w.y); v[j][3] = bfhi(w.y); v[j][4] = bflo(w.z); v[j][5] = bfhi(w.z); v[j][6] = bflo(w.w); v[j][7] = bfhi(w.w);
#pragma unroll
                for (int e = 0; e < 8; ++e) s += v[j][e] * v[j][e]; }
            const float rstd = 1.0f / sqrtf(wave_sum(s) * (1.0f / DM) + NORM_EPS);
            u32x2* o8 = (u32x2*)(HF + (size_t)row * DM) + lane;
#pragma unroll
            for (int j = 0; j < 4; ++j) { const int c8 = 2 * (64 * j + lane);
                float h[8];
#pragma unroll
                for (int q = 0; q < 2; ++q) { const f32x4 nw = ((const f32x4*)p.norm_ffn_w)[c8 + q], sh = ((const f32x4*)(mod + b * 12288 + 3 * 2048))[c8 + q], sc = ((const f32x4*)(mod + b * 12288 + 4 * 2048))[c8 + q];
#pragma unroll
                    for (int e = 0; e < 4; ++e) h[4 * q + e] = v[j][4 * q + e] * rstd * nw[e] * (sc[e] + 1.0f) + sh[e]; }
                o8[64 * j] = cvt8_fp8(h);
                LAS f32x2* d = (LAS f32x2*)(hfs + li * P7_LD + 4 * c8); d[0] = (f32x2){h[0], h[1]}; d[1] = (f32x2){h[2], h[3]}; d[2] = (f32x2){h[4], h[5]}; d[3] = (f32x2){h[6], h[7]}; }
        }
    }
    __syncthreads();
    {
        const int i = lane & 15, kq = lane >> 4, k0 = 256 * wave + 32 * kq;
        const float* WrT = (const float*)(p.ws + WS_WRT);
        const float* w0 = WrT + (size_t)i * DM + k0; const float* w1 = WrT + (size_t)(16 + i) * DM + k0; const float* w2 = WrT + (size_t)(32 + i) * DM + k0;
        const LAS float* ap = hfs + i * P7_LD + k0;
        f32x4 a0 = {0.f, 0.f, 0.f, 0.f}, a1 = a0, a2 = a0;
#pragma unroll
        for (int blk = 0; blk < 4; ++blk) { const int ko = 128 * (blk >> 1) + 16 * (blk & 1);
            f32x4 b0[4], b1[4], b2[4]; f32x2 av[8];
#pragma unroll
            for (int q = 0; q < 4; ++q) { b0[q] = *(const f32x4*)(w0 + ko + 4 * q); b1[q] = *(const f32x4*)(w1 + ko + 4 * q); b2[q] = *(const f32x4*)(w2 + ko + 4 * q); }
#pragma unroll
            for (int q = 0; q < 8; ++q) av[q] = *(const LAS f32x2*)(ap + ko + 2 * q);
#pragma unroll
            for (int q = 0; q < 4; ++q)
#pragma unroll
                for (int e = 0; e < 4; ++e) { const float a = av[2 * q + (e >> 1)][e & 1];
                    a0 = __builtin_amdgcn_mfma_f32_16x16x4f32(a, b0[q][e], a0, 0, 0, 0);
                    a1 = __builtin_amdgcn_mfma_f32_16x16x4f32(a, b1[q][e], a1, 0, 0, 0);
                    a2 = __builtin_amdgcn_mfma_f32_16x16x4f32(a, b2[q][e], a2, 0, 0, 0); }
        }
        LAS f32x4* rw = (LAS f32x4*)red + (wave * 3) * 64 + lane; rw[0] = a0; rw[64] = a1; rw[128] = a2;
    }
    __syncthreads();
    if (tid < 256) {
        const int i = tid >> 4, n = tid & 15, src_lane = (i >> 2) * 16 + n, j = i & 3;
        LAS float* lgs = (LAS float*)(lds + 156160) + (slot * 16 + i) * 36;
#pragma unroll
        for (int tl = 0; tl < 3; ++tl) { float s = 0.f;
#pragma unroll
            for (int w = 0; w < 8; ++w) s += red[((w * 3 + tl) * 64 + src_lane) * 4 + j];
            if (tl == 0) { if (n < 4) lgs[n] = s; } else lgs[4 + (tl - 1) * 16 + n] = s; }
    }
}
__device__ __forceinline__ void p7_finish(const Params& p, LAS unsigned char* lds, int row_first, int row_stride, int nrows, int tid, int cnt_off) {
    unsigned* tok = (unsigned*)(p.ws + WS_TOK); unsigned* cnt = (unsigned*)(p.ws + WS_CTL) + CW_CNT + cnt_off;
    const LAS float* lgs = (const LAS float*)(lds + 156160); LAS unsigned* lcnt = (LAS unsigned*)(lds + 156160 + 4608); LAS unsigned* lbase = lcnt + 32;
    __syncthreads();
    int e0 = 0, e1 = 0; unsigned r0 = 0u, r1 = 0u; float w0 = 0.f, w1 = 0.f;
    if (tid < nrows) {
        const LAS float* L = lgs + tid * 36;
        float gl[4];
#pragma unroll
        for (int q = 0; q < 4; ++q) gl[q] = L[q] + p.b_rg[q];
        int gsel = 0; float gmax = gl[0];
#pragma unroll
        for (int q = 1; q < 4; ++q) if (gl[q] > gmax) { gmax = gl[q]; gsel = q; }
        float gden = 0.f;
#pragma unroll
        for (int q = 0; q < 4; ++q) gden += __expf(gl[q] - gmax);
        const float gwt = 1.0f / gden;
        float el[8];
#pragma unroll
        for (int q = 0; q < 8; ++q) el[q] = L[4 + gsel * 8 + q] + p.b_re[gsel * 8 + q];
        int i0 = 0; float v0 = el[0];
#pragma unroll
        for (int q = 1; q < 8; ++q) if (el[q] > v0) { v0 = el[q]; i0 = q; }
        int i1 = -1; float v1 = -3.0e38f;
#pragma unroll
        for (int q = 0; q < 8; ++q) if (q != i0 && el[q] > v1) { v1 = el[q]; i1 = q; }
        const float ex = __expf(v1 - v0); w0 = gwt / (1.0f + ex); w1 = gwt * ex / (1.0f + ex);
        e0 = gsel * 8 + i0; e1 = gsel * 8 + i1;
        r0 = __hip_atomic_fetch_add(lcnt + e0, 1u, __ATOMIC_RELAXED, __HIP_MEMORY_SCOPE_WORKGROUP); r1 = __hip_atomic_fetch_add(lcnt + e1, 1u, __ATOMIC_RELAXED, __HIP_MEMORY_SCOPE_WORKGROUP);
    }
    __syncthreads();
    if (tid < 32) { const unsigned c = lcnt[tid]; lbase[tid] = c ? atomicAdd(cnt + 64 * tid, c) : 0u; }
    __syncthreads();
    if (tid < nrows) { const size_t row = (size_t)row_first + (size_t)(tid >> 4) * row_stride + (tid & 15);
        u32x4 a; a.x = (unsigned)e0; a.y = lbase[e0] + r0; a.z = __float_as_uint(w0); a.w = (unsigned)e1; u32x4 c2; c2.x = lbase[e1] + r1; c2.y = __float_as_uint(w1); c2.z = 0u; c2.w = 0u;
        *(u32x4*)(tok + row * 8) = a; *(u32x4*)(tok + row * 8 + 4) = c2; }
    __syncthreads();
}
__device__ __forceinline__ int expert_offsets(const Params& p, int lane, int& padded, int& tot, int& cnt_out) {
    const unsigned* cnt = (const unsigned*)(p.ws + WS_CTL) + CW_CNT;
    const int ce = (int)__hip_atomic_load(cnt + 64 * (lane & 31), __ATOMIC_RELAXED, __HIP_MEMORY_SCOPE_AGENT);
    cnt_out = ce; padded = (ce + 255) & ~255; int off = 0, total = 0;
#pragma unroll
    for (int e = 0; e < 32; ++e) { const int pe = __builtin_amdgcn_readlane(padded, e); if (e < (lane & 31)) off += pe; total += pe; }
    tot = total;
    return off;
}
__device__ __forceinline__ void p8_rows(const Params& p, int gw, int NGW, int lane) {
    unsigned* tok = (unsigned*)(p.ws + WS_TOK); float* wslot = (float*)(p.ws + WS_WSLOT); int* s2t = (int*)(p.ws + WS_S2T);
    int padded, tot, ce; const int off = expert_offsets(p, lane, padded, tot, ce);
    for (int base = gw * 64; base < MTOK; base += NGW * 64) { const int row = base + lane;
        const u32x4 a = *(const u32x4*)(tok + (size_t)row * 8); const u32x4 c2 = *(const u32x4*)(tok + (size_t)row * 8 + 4);
        const int s0 = __builtin_amdgcn_ds_bpermute((int)a.x << 2, off) + (int)a.y, s1 = __builtin_amdgcn_ds_bpermute((int)a.w << 2, off) + (int)c2.x;
        tok[(size_t)row * 8 + 6] = (unsigned)s0; tok[(size_t)row * 8 + 7] = (unsigned)s1; wslot[s0] = __uint_as_float(a.z); wslot[s1] = __uint_as_float(c2.y);
        s2t[s0] = row; s2t[s1] = row; }
    for (int e = gw; e < NEXP; e += NGW) {
        const int o = __builtin_amdgcn_ds_bpermute(e << 2, off), c = __builtin_amdgcn_ds_bpermute(e << 2, ce), pd = __builtin_amdgcn_ds_bpermute(e << 2, padded);
        for (int i = c + lane; i < pd; i += 64) s2t[o + i] = 0; }
}
__device__ __forceinline__ void build_tile_table(const Params& p, LAS unsigned char* lds, int tid, int lane) {
    LAS int* tx = (LAS int*)(lds + TEXP_OFF);
    if (tid < 64) { int padded, tot, ce_; const int off = expert_offsets(p, lane, padded, tot, ce_);
        if (lane < 32) { const int t0 = off >> 8, nt = padded >> 8; for (int t = 0; t < nt; ++t) tx[1 + t0 + t] = lane; }
        if (lane == 0) tx[0] = tot >> 8; }
    __syncthreads();
}
template <bool GATH> struct MoeSched {
    static constexpr bool GATHER = GATH;
    const char* A; const char* W; const LAS int* tx; const int* s2t; int lda2x256, wtile, ntn, G, c;
    __device__ __forceinline__ bool next(int i, pg8::Unit& u) const {
        const int T = __builtin_amdgcn_readfirstlane(tx[0]);
        int t, nt;
        if ((G & 7) == 0) {
            const int x = c & 7, w = c >> 3, wpx = G >> 3, TPX = (T + 7) >> 3, li = i * wpx + w;
            const int j = li / ntn; nt = li - j * ntn; t = x * TPX + j; if (j >= TPX || t >= T) return false;
        } else { const int L = i * G + c; t = L / ntn; nt = L - t * ntn; if (t >= T) return false; }
        const int e = __builtin_amdgcn_readfirstlane(tx[1 + t]);
        u.a = GATH ? A : A + (size_t)t * lda2x256; u.b = W + (size_t)(e * ntn + nt) * wtile; u.i0 = t; u.i1 = nt; u.i2 = e; u.i3 = 0; return true;
    }
    __device__ __forceinline__ void rows(const pg8::Unit& u, const int (&R)[2], const int (&C)[2], unsigned (&g0)[2], unsigned (&g1)[2]) const {
        const int* l = s2t + u.i0 * 256;
#pragma unroll
        for (int i = 0; i < 2; ++i) { const unsigned t0 = (unsigned)l[R[i]], t1 = (unsigned)l[128 + R[i]]; g0[i] = t0 * (unsigned)DM + (unsigned)C[i] * 2u; g1[i] = t1 * (unsigned)DM + (unsigned)C[i] * 2u; }
    }
};
struct EpiGateUp {
    static constexpr bool PERM = true, CHAIN = false, AFTER_DRAIN = false;
    unsigned char* act;
    __device__ __forceinline__ void operator()(const f32x4 (&acc)[2][2][4][2], const pg8::Unit& u, int wr, int wc, int fr, int fq) const {
        asm volatile("" : "+v"(fr), "+v"(fq));
        const int col0 = 128 * u.i1 + 32 * wc + 8 * fq; const float ws = 1.0f / W8_SCALE;
#pragma unroll
        for (int ai = 0; ai < 2; ++ai)
#pragma unroll
            for (int m = 0; m < 4; ++m) { const size_t slot = (size_t)256 * u.i0 + 128 * ai + 64 * wr + 16 * m + fr;
                float r[8];
#pragma unroll
                for (int n = 0; n < 2; ++n)
#pragma unroll
                    for (int e = 0; e < 4; ++e) r[4 * n + e] = silu_f(acc[ai][0][m][n][e] * ws) * (acc[ai][1][m][n][e] * (ws * A8_SCALE));
                *(u32x2*)(act + slot * FF + col0) = cvt8_fp8(r); }
    }
};
struct EpiDown {
    static constexpr bool PERM = true, CHAIN = false, AFTER_DRAIN = false;
    bf16_t* y; const float* wslot;
    __device__ __forceinline__ void operator()(const f32x4 (&acc)[2][2][4][2], const pg8::Unit& u, int wr, int wc, int fr, int fq) const {
        asm volatile("" : "+v"(fr), "+v"(fq));
        const int col0 = 256 * u.i1 + 32 * wc + 8 * fq;
        float wsv[2][4];
#pragma unroll
        for (int ai = 0; ai < 2; ++ai)
#pragma unroll
            for (int m = 0; m < 4; ++m) wsv[ai][m] = wslot[(size_t)256 * u.i0 + 128 * ai + 64 * wr + 16 * m + fr];
#pragma unroll
        for (int ai = 0; ai < 2; ++ai)
#pragma unroll
            for (int m = 0; m < 4; ++m) { const size_t slot = (size_t)256 * u.i0 + 128 * ai + 64 * wr + 16 * m + fr; const float ws_ = wsv[ai][m] * (1.0f / (W8_SCALE * A8_SCALE));
#pragma unroll
                for (int bj = 0; bj < 2; ++bj) { const f32x4 v0 = acc[ai][bj][m][0] * ws_, v1 = acc[ai][bj][m][1] * ws_;
                    u32x4 w; w.x = cvt_pk_bf16(v0[0], v0[1]); w.y = cvt_pk_bf16(v0[2], v0[3]); w.z = cvt_pk_bf16(v1[0], v1[1]); w.w = cvt_pk_bf16(v1[2], v1[3]);
                    *(u32x4*)(y + slot * DM + col0 + 128 * bj) = w; } }
    }
};
__device__ __forceinline__ void p11_rows(const Params& p, int gw, int NGW, int lane) {
    const float* mod = (const float*)(p.ws + WS_MOD); const bf16_t* X1 = (const bf16_t*)(p.ws + WS_X1); const bf16_t* Y = (const bf16_t*)(p.ws + WS_Y); const unsigned* tok = (const unsigned*)(p.ws + WS_TOK);
    for (int row = gw; row < MTOK; row += NGW) {
        const int b = row >> 12;
        const u32x4* xr = (const u32x4*)(X1 + (size_t)row * DM) + lane;
        float v[4][8]; float s = 0.f;
#if DBG_MODE == 1
#pragma unroll
        for (int j = 0; j < 4; ++j) { const u32x4 w = xr[64 * j]; v[j][0] = bflo(w.x); v[j][1] = bfhi(w.x); v[j][2] = bflo(w.y); v[j][3] = bfhi(w.y); v[j][4] = bflo(w.z); v[j][5] = bfhi(w.z); v[j][6] = bflo(w.w); v[j][7] = bfhi(w.w); }
#else
        const int s0 = (int)tok[(size_t)row * 8 + 6], s1 = (int)tok[(size_t)row * 8 + 7];
        const u32x4* y0 = (const u32x4*)(Y + (size_t)s0 * DM) + lane; const u32x4* y1 = (const u32x4*)(Y + (size_t)s1 * DM) + lane;
#pragma unroll
        for (int j = 0; j < 4; ++j) { const int c8 = 2 * (64 * j + lane); const u32x4 w = __builtin_nontemporal_load(xr + 64 * j), a = __builtin_nontemporal_load(y0 + 64 * j), c2 = __builtin_nontemporal_load(y1 + 64 * j);
            const f32x4 g0 = ((const f32x4*)(mod + b * 12288 + 5 * 2048))[c8], g1 = ((const f32x4*)(mod + b * 12288 + 5 * 2048))[c8 + 1];
            v[j][0] = bflo(w.x) + g0[0] * (bflo(a.x) + bflo(c2.x)); v[j][1] = bfhi(w.x) + g0[1] * (bfhi(a.x) + bfhi(c2.x));
            v[j][2] = bflo(w.y) + g0[2] * (bflo(a.y) + bflo(c2.y)); v[j][3] = bfhi(w.y) + g0[3] * (bfhi(a.y) + bfhi(c2.y));
            v[j][4] = bflo(w.z) + g1[0] * (bflo(a.z) + bflo(c2.z)); v[j][5] = bfhi(w.z) + g1[1] * (bfhi(a.z) + bfhi(c2.z));
            v[j][6] = bflo(w.w) + g1[2] * (bflo(a.w) + bflo(c2.w)); v[j][7] = bfhi(w.w) + g1[3] * (bfhi(a.w) + bfhi(c2.w)); }
#endif
#pragma unroll
        for (int j = 0; j < 4; ++j)
#pragma unroll
            for (int e = 0; e < 8; ++e) s += v[j][e] * v[j][e];
        const float rstd = 1.0f / sqrtf(wave_sum(s) * (1.0f / DM) + NORM_EPS);
        f32x4* orow = (f32x4*)(p.out + (size_t)row * DM);
#pragma unroll
        for (int j = 0; j < 4; ++j) { const int c8 = 2 * (64 * j + lane); const f32x4 f0 = ((const f32x4*)p.final_norm_w)[c8], f1 = ((const f32x4*)p.final_norm_w)[c8 + 1];
            __builtin_nontemporal_store((f32x4){v[j][0] * rstd * f0[0], v[j][1] * rstd * f0[1], v[j][2] * rstd * f0[2], v[j][3] * rstd * f0[3]}, orow + c8);
            __builtin_nontemporal_store((f32x4){v[j][4] * rstd * f1[0], v[j][5] * rstd * f1[1], v[j][6] * rstd * f1[2], v[j][7] * rstd * f1[3]}, orow + c8 + 1); }
    }
}

constexpr int NCHAIN = 32;
__global__ void __launch_bounds__(NWAVES * 64, 2) fwd_megakernel(Params p) {
    extern __shared__ __attribute__((aligned(16))) unsigned char lds_raw[];
    LAS unsigned char* lds = (LAS unsigned char*)lds_raw;
    const int G = gridDim.x, bx = blockIdx.x;
    const int vcu = (G % 8 == 0) ? (bx % 8) * (G / 8) + bx / 8 : bx;
    const int NGW = G * NWAVES;
    const int wave_s = __builtin_amdgcn_readfirstlane((int)threadIdx.x >> 6);
#define FRESH_IDS() int lane; asm volatile("v_mbcnt_lo_u32_b32 %0, -1, 0\n\tv_mbcnt_hi_u32_b32 %0, -1, %0" : "=v"(lane)); const int wave = wave_s, tid = wave * 64 + lane, gw = vcu * NWAVES + wave; (void)tid; (void)gw
    volatile LAS unsigned* MISC = (volatile LAS unsigned*)(lds + MISC_OFF);
    { FRESH_IDS(); for (int u = tid; u < (LDS_BYTES - CTL_OFF) / 4; u += NWAVES * 64) ((LAS unsigned*)(lds + CTL_OFF))[u] = 0u; }
    __syncthreads();
    unsigned* ctl = (unsigned*)(p.ws + WS_CTL);
    XcdBarrier bar = xcd_barrier_post(ctl + CW_BAR, MISC + 8);

    _Pragma("unroll 1") for (int rep_ = 0; rep_ < ((REP & 1) ? 2 : 1); ++rep_) {
    if (PHASES & 1) { FRESH_IDS(); if (bx < 192) p0_mod_item(p, lds, bx, tid, wave, lane);
        { float* WrT = (float*)(p.ws + WS_WRT); for (int idx = gw * 64 + lane; idx < 48 * 2048; idx += NGW * 64) { const int c = idx >> 11, k = idx & 2047;
            WrT[idx] = c < 4 ? p.w_rg[k * 4 + c] : (c < 16 ? 0.f : p.w_re[((size_t)((c - 16) >> 3) * DM + k) * 8 + ((c - 16) & 7)]); } }
        conv_range(p, lds, 0, CV_P3, gw, NGW, wave, lane);
        if (wave == 0) { unsigned* rdy = (unsigned*)(p.ws + WS_CTL) + CW_MODRDY; unsigned sp = 0;
            while ((unsigned)__builtin_amdgcn_readfirstlane(__hip_atomic_load(rdy, __ATOMIC_RELAXED, __HIP_MEMORY_SCOPE_AGENT)) < 192u && ++sp < (1u << 22)) __builtin_amdgcn_s_sleep(2);
            __builtin_amdgcn_fence(__ATOMIC_ACQUIRE, "agent"); asm volatile("s_waitcnt vmcnt(0)" ::: "memory"); }
        __syncthreads(); }
    }
    _Pragma("unroll 1") for (int rep_ = 0; rep_ < ((REP & 2) ? 2 : 1); ++rep_) {
    if (PHASES & 2) { FRESH_IDS(); p1_rows(p, gw, NGW, lane); }
    xcd_barrier(bar);
    }
    _Pragma("unroll 1") for (int rep_ = 0; rep_ < ((REP & 4) ? 2 : 1); ++rep_) {
    if (PHASES & 4) {
        InProjSched S{(const char*)(p.ws + WS_HX), (const char*)(p.ws + WS_WIN), G, bx};
        EpiInProj E{p.ws, p.ret_decay_f, p.ret_decay_b};
        pg8::gemm_phase<EpiInProj, InProjSched, true>(lds, wave_s, DM, DM, DM, S, E);
        InProjSched8 S8{(const char*)(p.ws + WS_X1), (const char*)(p.ws + WS_WIN), G - 16, bx - 16};
        pg8::gemm_phase<EpiInProj, InProjSched8, true, 1>(lds, wave_s, DM, DM, DM / 2, S8, E);
        if (rep_ == 0 && bx >= 176 && G == 256) { FRESH_IDS(); conv_range(p, lds, CV_P0, CV_P2, (bx - 176) * NWAVES + wave, 80 * NWAVES, wave, lane); }
        else if (rep_ == 0 && G != 256) { FRESH_IDS(); conv_range(p, lds, CV_P0, CV_P2, gw, NGW, wave, lane); }
    }
    xcd_barrier(bar);
    }
    _Pragma("unroll 1") for (int rep_ = 0; rep_ < ((REP & 24) ? 2 : 1); ++rep_) {
    if (bx < NCHAIN) {
        if ((PHASES & 16) && (rep_ == 0 || (REP & 16))) {
        const int rh = bx & 1, dir = (bx >> 1) & 1, bh = bx >> 2, h = bh & 3;
        const char* svp = (const char*)(p.ws + WS_SV) + ((size_t)bh * 16 * 256 * 768 + (size_t)rh * 128 * 768 + 512) * 2;
        const char* svcp = (const char*)(p.ws + WS_SVC) + ((size_t)bh * 256 * 768 + (size_t)rh * 128 * 768 + 512) * 2;
        const char* kTp = (const char*)(p.ws + (dir == 0 ? WS_KTF : WS_KTB)) + (size_t)bh * 256 * LDT * 2;
        ChainSched S{svp, svcp, kTp, dir};
        const float lg = log2_sigmoid(dir == 0 ? p.ret_decay_f[h] : p.ret_decay_b[h]);
        EpiChain E{(bf16_t*)(p.ws + WS_SV) + (size_t)bh * 16 * 256 * 768 + (size_t)rh * 128 * 768, dir, exp2f(lg * 256.0f)};
        pg8::gemm_phase<EpiChain, ChainSched, true, 0, 1>(lds, wave_s, 768, LDT, 256, S, E); }
    } else {
#if DBG_MODE != 3
        if ((PHASES & 32) && rep_ == 0) {
            ScoreSched S{(const char*)(p.ws + WS_Q), (const char*)(p.ws + WS_K), bx < NCHAIN + 128 ? bx - NCHAIN : -1};
            EpiScore E{(bf16_t*)(p.ws + WS_QP), p.ret_decay_f, p.ret_decay_b};
            pg8::gemm_phase<EpiScore, ScoreSched, true>(lds, wave_s, 1024, 1024, 256, S, E); }
        if ((PHASES & 8) && (rep_ == 0 || (REP & 8))) { FRESH_IDS();
        if (G == 256) {
            const int xl = bx & 7, vl = (bx >> 3) - NCHAIN / 8; for (int item = 128 * xl + vl; item < 128 * xl + 128; item += 32 - NCHAIN / 8) na_wg_item(p, lds, item, wave, lane);
            if (rep_ == 0) conv_range(p, lds, CV_P3, CV_P0, (bx - NCHAIN) * NWAVES + wave, (256 - NCHAIN) * NWAVES, wave, lane);
        } else { for (int item = bx - NCHAIN; item < 1024; item += G - NCHAIN) na_wg_item(p, lds, item, wave, lane);
            if (rep_ == 0) conv_range(p, lds, CV_P3, CV_P0, (bx - NCHAIN) * NWAVES + wave, (G - NCHAIN) * NWAVES, wave, lane); } }
#endif
    }
    xcd_barrier(bar);
    }
    _Pragma("unroll 1") for (int rep_ = 0; rep_ < ((REP & 32) ? 2 : 1); ++rep_) {
#if DBG_MODE != 2
    if (PHASES & 32) {
        RetOutSched S{(const char*)(p.ws + WS_QP), (const char*)(p.ws + WS_SV), bx < 128 ? bx : -1};
        EpiRetOut E{(const bf16_t*)(p.ws + WS_G), p.ret_gn_w, (bf16_t*)(p.ws + WS_MIX)};
        pg8::gemm_phase<EpiRetOut, RetOutSched, true>(lds, wave_s, 768, 768, 768, S, E);
        if (rep_ == 0 && bx >= 128 && G == 256) { FRESH_IDS(); conv_range(p, lds, CV_P2, CV_P9, (bx - 128) * NWAVES + wave, 128 * NWAVES, wave, lane); }
        else if (rep_ == 0 && G != 256) { FRESH_IDS(); conv_range(p, lds, CV_P2, CV_P9, gw, NGW, wave, lane); } }
#endif
    xcd_barrier(bar);
    }
    _Pragma("unroll 1") for (int rep_ = 0; rep_ < ((REP & 64) ? 2 : 1); ++rep_) {
    if (PHASES & 64) {
        OutProjSched S{(const char*)(p.ws + WS_MIX), (const char*)(p.ws + WS_WOUT), G, bx};
        EpiOutProj E{p.x, (const float*)(p.ws + WS_MOD), (bf16_t*)(p.ws + WS_X1)};
        pg8::gemm_phase<EpiOutProj, OutProjSched, true, 1>(lds, wave_s, DM, DM, DM / 2, S, E);
    }
    xcd_barrier(bar);
    }
#if DBG_MODE != 1
    _Pragma("unroll 1") for (int rep_ = 0; rep_ < ((REP & 128) ? 2 : 1); ++rep_) {
    if (PHASES & 128) { FRESH_IDS(); if (tid < 32) ((LAS unsigned*)(lds + 156160 + 4608))[tid] = 0u;
        int slot = 0; for (int item = bx; item < 512 && slot < 2; item += G, ++slot) p7_item(p, lds, item, slot, tid, wave, lane);
        p7_finish(p, lds, 16 * bx, 16 * G, 16 * slot, tid, ((REP & 128) && rep_ == 0) ? 4096 : 0); }
    xcd_barrier(bar);
    }
    _Pragma("unroll 1") for (int rep_ = 0; rep_ < ((REP & 256) ? 2 : 1); ++rep_) {
    if (PHASES & 256) { FRESH_IDS(); p8_rows(p, gw, NGW, lane);
        build_tile_table(p, lds, tid, lane); }
    xcd_barrier(bar);
    }
    _Pragma("unroll 1") for (int rep_ = 0; rep_ < ((REP & 512) ? 2 : 1); ++rep_) {
    if (PHASES & 512) {
        MoeSched<true> S{(const char*)(p.ws + WS_HF), (const char*)(p.ws + WS_WGU), (const LAS int*)(lds + TEXP_OFF), (const int*)(p.ws + WS_S2T), 256 * DM, 256 * DM, 4, G, bx};
        EpiGateUp E{p.ws + WS_ACT};
        pg8::gemm_phase<EpiGateUp, MoeSched<true>, true, 1>(lds, wave_s, DM / 2, DM / 2, DM / 2, S, E);
        if (rep_ == 0) { FRESH_IDS(); const int T9 = ((const LAS int*)(lds + TEXP_OFF))[0];
            if ((G & 7) == 0) { const int wpx = G >> 3, TPX = (T9 + 7) >> 3, x = bx & 7, w = bx >> 3; int before = 0, total = 0, hw_me = 0;
                for (int xx = 0; xx < 8; ++xx) { const int tiles = min(max(T9 - xx * TPX, 0), TPX), hw = min(max(4 * tiles - wpx, 0), wpx); if (xx < x) before += wpx - hw; if (xx == x) hw_me = hw; total += wpx - hw; }
                if (total == 0) conv_range(p, lds, CV_P9, NCONV, gw, NGW, wave, lane);
                else if (w >= hw_me) conv_range(p, lds, CV_P9, NCONV, (before + w - hw_me) * NWAVES + wave, total * NWAVES, wave, lane);
            } else { const int n9 = 4 * T9, heavy = min(max(n9 - G, 0), G - 1); if (bx >= heavy) conv_range(p, lds, CV_P9, NCONV, (bx - heavy) * NWAVES + wave, (G - heavy) * NWAVES, wave, lane); } }
    }
    xcd_barrier(bar);
    }
    _Pragma("unroll 1") for (int rep_ = 0; rep_ < ((REP & 1024) ? 2 : 1); ++rep_) {
    if (PHASES & 1024) {
        MoeSched<false> S{(const char*)(p.ws + WS_ACT), (const char*)(p.ws + WS_WD), (const LAS int*)(lds + TEXP_OFF), nullptr, 256 * FF, 256 * FF, 8, G, bx};
        EpiDown E{(bf16_t*)(p.ws + WS_Y), (const float*)(p.ws + WS_WSLOT)};
        pg8::gemm_phase<EpiDown, MoeSched<false>, true, 1>(lds, wave_s, FF / 2, FF / 2, FF / 2, S, E);
    }
    xcd_barrier(bar);
    }
#endif
    _Pragma("unroll 1") for (int rep_ = 0; rep_ < ((REP & 2048) ? 2 : 1); ++rep_) {
    if (PHASES & 2048) { FRESH_IDS(); p11_rows(p, gw, NGW, lane); }
    }
#undef FRESH_IDS
}

extern "C" void kernel_launch(void* const* d_in, const int* in_sizes, int n_in, void* d_out, int out_size, void* d_ws, size_t ws_size, hipStream_t stream) {
    static int grid = 0;
    if (grid == 0) {
        if (n_in != 22 || ws_size < WS_END) { fprintf(stderr, "kernel_launch: unexpected inputs (n_in %d, ws %zu, need %zu)\n", n_in, ws_size, (size_t)WS_END); grid = -1; return; }
        int dev = 0, cus = 0;
        if (hipGetDevice(&dev) != hipSuccess || hipDeviceGetAttribute(&cus, hipDeviceAttributeMultiprocessorCount, dev) != hipSuccess) { grid = -1; return; }
        if (hipFuncSetAttribute((const void*)fwd_megakernel, hipFuncAttributeMaxDynamicSharedMemorySize, LDS_BYTES) != hipSuccess) { fprintf(stderr, "kernel_launch: hipFuncSetAttribute failed\n"); grid = -1; return; }
        (void)hipGetLastError();
        grid = cus;
    }
    if (grid < 0) return;
    (void)hipMemsetAsync((char*)d_ws + WS_CTL, 0, CTL_ZERO_BYTES, stream);
    Params p{};
    const float** pp = (const float**)&p;
    for (int i = 0; i < 22; ++i) pp[i] = (const float*)d_in[i];
    p.out = (float*)d_out; p.ws = (unsigned char*)d_ws;
    hipLaunchKernelGGL(fwd_megakernel, dim3(grid), dim3(NWAVES * 64), LDS_BYTES, stream, p);
}
```

```cpp
#include <hip/hip_runtime.h>
#include <cstdio>
#include <cstdint>

#define LAS __attribute__((address_space(3)))
#define GAS __attribute__((address_space(1)))
typedef unsigned short bf16_t;
typedef short bf16x8 __attribute__((ext_vector_type(8)));
typedef short s16x4 __attribute__((ext_vector_type(4)));
typedef float f32x4 __attribute__((ext_vector_type(4)));
typedef float f32x2 __attribute__((ext_vector_type(2)));
typedef unsigned u32x4 __attribute__((ext_vector_type(4)));
typedef unsigned u32x2 __attribute__((ext_vector_type(2)));

#ifndef PHASES
#define PHASES 0xFFFF
#endif
#ifndef REP
#define REP 0
#endif
#ifndef DBG_MODE
#define DBG_MODE 0
#endif

constexpr int DM = 2048, SEQ = 4096, MTOK = 8192, CTXL = 256, MALL = 8704, NIN = 7168;
constexpr int LDT = 4352;
constexpr int NEXP = 32, FF = 512, MAXSLOT = 24576;
constexpr float NORM_EPS = 1e-6f;
constexpr float LOG2E = 1.4426950408889634f;

constexpr size_t MiB = 1u << 20;
constexpr size_t WS_CTL = 0, CTL_ZERO_BYTES = 65536;
constexpr size_t WS_MOD = 1 * MiB;
constexpr size_t WS_TOK = 2 * MiB;
constexpr size_t WS_WSLOT = 2 * MiB + 512 * 1024;
constexpr size_t WS_S2T = 3 * MiB;
constexpr size_t WS_WRT = 3 * MiB + 512 * 1024;
constexpr size_t WS_WIN = 4 * MiB, WS_WOUT = 32 * MiB, WS_WGU = 40 * MiB, WS_WD = 168 * MiB, WS_X1 = 232 * MiB;
constexpr size_t WS_E = 296 * MiB;
constexpr size_t WS_HX = WS_E, WS_Q = WS_E + 34 * MiB, WS_K = WS_E + 50 * MiB, WS_G = WS_E + 66 * MiB, WS_NQ = WS_E + 82 * MiB, WS_NK = WS_E + 98 * MiB;
constexpr size_t WS_KTF = WS_E + 115 * MiB, WS_KTB = WS_E + 132 * MiB, WS_NVT = WS_E + 149 * MiB;
constexpr size_t WS_SV = WS_E + 166 * MiB;
constexpr size_t WS_SVC = WS_E + 214 * MiB;
constexpr size_t WS_QP = WS_E + 217 * MiB;
constexpr size_t WS_MIX = WS_E + 265 * MiB;
constexpr size_t WS_HF = WS_E, WS_HFS = WS_E + 32 * MiB, WS_ACT = WS_E + 128 * MiB, WS_Y = WS_E + 152 * MiB;
constexpr size_t WS_END = WS_E + 297 * MiB;
constexpr int CW_BAR = 4096, CW_CNT = 8192, CW_MODRDY = 12288;

constexpr int RING_BYTES = 131072, CTL_OFF = 161792, MISC_OFF = CTL_OFF + 320, TEXP_OFF = CTL_OFF + 1024, LDS_BYTES = 163840;
constexpr int NWAVES = 8;

__device__ __forceinline__ unsigned cvt_pk_bf16(float lo, float hi) { unsigned r; asm volatile("v_cvt_pk_bf16_f32 %0, %1, %2" : "=v"(r) : "v"(lo), "v"(hi)); return r; }
typedef int v8i __attribute__((ext_vector_type(8)));
typedef int v4i __attribute__((ext_vector_type(4)));
constexpr float W8_SCALE = 64.0f, A8_SCALE = 8.0f, MIX8_SCALE = 16.0f;
__device__ __forceinline__ u32x2 cvt8_fp8(const float (&h)[8]) { int lo = __builtin_amdgcn_cvt_pk_fp8_f32(h[0], h[1], 0, false); lo = __builtin_amdgcn_cvt_pk_fp8_f32(h[2], h[3], lo, true);
    int hi = __builtin_amdgcn_cvt_pk_fp8_f32(h[4], h[5], 0, false); hi = __builtin_amdgcn_cvt_pk_fp8_f32(h[6], h[7], hi, true); u32x2 r; r.x = (unsigned)lo; r.y = (unsigned)hi; return r; }
__device__ __forceinline__ float bf2f(unsigned short h) { return __uint_as_float((unsigned)h << 16); }
__device__ __forceinline__ float bflo(unsigned w) { return __uint_as_float(w << 16); }
__device__ __forceinline__ float bfhi(unsigned w) { return __uint_as_float(w & 0xffff0000u); }
template <int X> __device__ __forceinline__ float lane_xor(float v) { return __int_as_float(__builtin_amdgcn_ds_swizzle(__float_as_int(v), (X << 10) | 0x1f)); }
__device__ __forceinline__ float half_sum(float v) { const auto r = __builtin_amdgcn_permlane32_swap(__float_as_uint(v), __float_as_uint(v), false, false); return __uint_as_float(r[0]) + __uint_as_float(r[1]); }
__device__ __forceinline__ float half_max(float v) { const auto r = __builtin_amdgcn_permlane32_swap(__float_as_uint(v), __float_as_uint(v), false, false); return fmaxf(__uint_as_float(r[0]), __uint_as_float(r[1])); }
__device__ __forceinline__ float sum_g4(float v) { v += lane_xor<16>(v); return half_sum(v); }
__device__ __forceinline__ float max_g4(float v) { v = fmaxf(v, lane_xor<16>(v)); return half_max(v); }
__device__ __forceinline__ float wave_sum(float v) { v += lane_xor<1>(v); v += lane_xor<2>(v); v += lane_xor<4>(v); v += lane_xor<8>(v); v += lane_xor<16>(v); return half_sum(v); }
__device__ __forceinline__ float silu_f(float x) { return x * __builtin_amdgcn_rcpf(1.0f + __expf(-x)); }
__device__ __forceinline__ void sincos_ang(float ang, float& s, float& c) { float rev = ang * 0.15915494309189535f; rev = rev - floorf(rev); s = __builtin_amdgcn_sinf(rev); c = __builtin_amdgcn_cosf(rev); }
__device__ __forceinline__ float log2_sigmoid(float x) { return -log1pf(__expf(-x)) * LOG2E; }
#define LDS_WAIT() asm volatile("s_waitcnt lgkmcnt(0)" ::: "memory")
#define VM_WAIT() asm volatile("s_waitcnt vmcnt(0)" ::: "memory")

namespace pg8 {
constexpr int BM = 256, BK = 64, HALF = 128, HTB = HALF * BK * 2, STAGE_BYTES = 8 * HTB;
__device__ __forceinline__ int lds_byte(int r, int c) { const int st = (r >> 4) * 2 + (c >> 5), rr = r & 15, cc = c & 31, ob = rr * 64 + cc * 2; return st * 1024 + (ob ^ (((ob >> 9) & 1) << 5)); }
__device__ __forceinline__ void stage_rc(int b, int& R, int& C) { const int st = b / 1024, sb = b % 1024, swz = sb ^ (((sb >> 9) & 1) << 5); R = (st >> 1) * 16 + swz / 64; C = (st & 1) * 32 + (swz % 64) / 2; }
__device__ __forceinline__ int perm32(int rho) { const int n = rho >> 4, i = rho & 15; return 8 * (i >> 2) + 4 * n + (i & 3); }

struct Unit { const char* a; const char* b; int i0, i1, i2, i3; };

template <class Epi, class Sched, bool ALIGN_EPI, int MX = 0, int MH = 0>
__device__ __forceinline__ void gemm_phase(LAS unsigned char* lds, const int wid, const int lda, const int ldb, const int K, const Sched& S, const Epi& E) {
    int lane; asm volatile("v_mbcnt_lo_u32_b32 %0, -1, 0\n\tv_mbcnt_hi_u32_b32 %0, -1, %0" : "=v"(lane));
    const int tid = wid * 64 + lane, wr = wid >> 2, wc = wid & 3, fr = lane & 15, fq = lane >> 4;
    const int nt = K / BK;
    unsigned voffA[2], voffB[2]; int RA[2], CA[2];
#pragma unroll
    for (int i = 0; i < 2; ++i) { int R, C; stage_rc(tid * 16 + i * 8192, R, C); const int Rb = Epi::PERM ? (Sched::COLMAP64 ? (64 * ((R >> 5) & 3) + perm32(R & 31)) : ((R & ~31) + perm32(R & 31))) : R; RA[i] = R; CA[i] = C;
        voffA[i] = (unsigned)(R * lda + C) * 2u; voffB[i] = (unsigned)(Rb * ldb + C) * 2u; }
    unsigned gc0[2] = {0u, 0u}, gc1[2] = {0u, 0u}, gn0[2] = {0u, 0u}, gn1[2] = {0u, 0u};
    const size_t kstep = (size_t)(BK * 2);
    const size_t hstepA = (Sched::GATHER || MH) ? (size_t)0 : (size_t)HALF * lda * 2, hstepB = (size_t)(Sched::COLMAP64 ? 32 : HALF) * ldb * 2;
    const unsigned ldsw = (unsigned)wid * 1024u;
    const int aoff = lds_byte(wr * 64 + fr, fq * 8), boff = lds_byte(wc * 32 + fr, fq * 8);
#define PG8_SA(b, h) (((b) * 2 + (h)) * HTB)
#define PG8_SB(b, h) ((4 + (b) * 2 + (h)) * HTB)
#define PG8_STAGE(bufoff, gbase, voff) do { _Pragma("unroll") for (int _i = 0; _i < 2; ++_i) \
        __builtin_amdgcn_global_load_lds((const unsigned*)((const char*)(gbase) + (voff)[_i]), (LAS unsigned*)(lds + (bufoff) + ldsw + _i * 8192), 16, 0, 0); } while (0)
#define PG8_LDS16(off) (*(const LAS v4i*)(lds + (off)))
#define PG8_LDA(dst, b, h) do { if constexpr (MX == 0) { _Pragma("unroll") for (int m = 0; m < 4; ++m) _Pragma("unroll") for (int k = 0; k < 2; ++k) dst[m][k] = *(const LAS bf16x8*)(lds + PG8_SA(b, h) + aoff + m * 2048 + k * 1024); } \
        else { _Pragma("unroll") for (int m = 0; m < 4; ++m) dst##8[m] = __builtin_shufflevector(PG8_LDS16(PG8_SA(b, h) + aoff + m * 2048), PG8_LDS16(PG8_SA(b, h) + aoff + m * 2048 + 1024), 0, 1, 2, 3, 4, 5, 6, 7); } } while (0)
#define PG8_LDB(dst, b, h) do { if constexpr (MX == 0) { _Pragma("unroll") for (int n = 0; n < 2; ++n) _Pragma("unroll") for (int k = 0; k < 2; ++k) dst[n][k] = *(const LAS bf16x8*)(lds + PG8_SB(b, h) + boff + n * 2048 + k * 1024); } \
        else { _Pragma("unroll") for (int n = 0; n < 2; ++n) dst##8[n] = __builtin_shufflevector(PG8_LDS16(PG8_SB(b, h) + boff + n * 2048), PG8_LDS16(PG8_SB(b, h) + boff + n * 2048 + 1024), 0, 1, 2, 3, 4, 5, 6, 7); } } while (0)
#define PG8_MMA(ai, bj, At, Bt) do { __builtin_amdgcn_s_setprio(1); if constexpr (MX == 0) { _Pragma("unroll") for (int m = 0; m < 4; ++m) _Pragma("unroll") for (int n = 0; n < 2; ++n) _Pragma("unroll") for (int k = 0; k < 2; ++k) \
        acc[ai][bj][m][n] = __builtin_amdgcn_mfma_f32_16x16x32_bf16(Bt[n][k], At[m][k], acc[ai][bj][m][n], 0, 0, 0); } else { _Pragma("unroll") for (int m = 0; m < 4; ++m) _Pragma("unroll") for (int n = 0; n < 2; ++n) \
        asm volatile("v_mfma_scale_f32_16x16x128_f8f6f4 %0, %1, %2, %0, %3, %3 op_sel_hi:[0,0,0]" : "+v"(acc[ai][bj][m][n]) : "v"(Bt##8[n]), "v"(At##8[m]), "v"(mxs1)); } \
        __builtin_amdgcn_s_setprio(0); } while (0)
#define PG8_WAIT_V(n) asm volatile("s_waitcnt vmcnt(" #n ")" ::: "memory")
#define PG8_WAIT_L(n) asm volatile("s_waitcnt lgkmcnt(" #n ")" ::: "memory")
#define PG8_BAR __builtin_amdgcn_s_barrier()
#define PG8_SCHED __builtin_amdgcn_sched_barrier(0)
    Unit cur, nxt; int ui = 0;
    if (!S.next(0, cur)) return;
    f32x4 acc[2][2][4][2];
#pragma unroll
    for (int a = 0; a < 2; ++a)
#pragma unroll
        for (int b = 0; b < 2; ++b)
#pragma unroll
            for (int m = 0; m < 4; ++m)
#pragma unroll
                for (int n = 0; n < 2; ++n) acc[a][b][m][n] = (f32x4){0.f, 0.f, 0.f, 0.f};
    bf16x8 At[4][2], B0[2][2], B1[2][2];
    v8i At8[4], B08[2], B18[2];
    const int mxs1 = 0x7F7F7F7F;
    const char* cA = cur.a; const char* cB = cur.b;
    if constexpr (Sched::GATHER) S.rows(cur, RA, CA, gc0, gc1);
#define PG8_VA0C (Sched::GATHER ? gc0 : voffA)
#define PG8_VA1C (Sched::GATHER ? gc1 : voffA)
    PG8_STAGE(PG8_SB(0, 0), cB, voffB); PG8_STAGE(PG8_SB(0, 1), cB + hstepB, voffB); PG8_STAGE(PG8_SA(0, 0), cA, PG8_VA0C); PG8_STAGE(PG8_SA(0, 1), cA + hstepA, PG8_VA1C);
    if (wr == 1) PG8_BAR;
    PG8_WAIT_V(2); PG8_BAR;
    PG8_STAGE(PG8_SB(1, 0), cB + kstep, voffB); PG8_STAGE(PG8_SA(1, 0), cA + kstep, PG8_VA0C); PG8_STAGE(PG8_SB(1, 1), cB + hstepB + kstep, voffB);
    PG8_WAIT_V(6); PG8_BAR;
    for (;;) {
        const bool has_next = S.next(ui + 1, nxt);
        const char* nA = has_next ? nxt.a : cA; const char* nB = has_next ? nxt.b : cB;
        if constexpr (Sched::GATHER) { if (has_next) S.rows(nxt, RA, CA, gn0, gn1); else { gn0[0] = gc0[0]; gn0[1] = gc0[1]; gn1[0] = gc1[0]; gn1[1] = gc1[1]; } }
#pragma unroll 1
        for (int t = 0; t < nt; t += 2) {
            const bool last = (t == nt - 2);
            const char* a1 = cA + (size_t)(t + 1) * kstep;
            const char* a2 = last ? nA : cA + (size_t)(t + 2) * kstep; const char* b2 = last ? nB : cB + (size_t)(t + 2) * kstep;
            const char* a3 = a2 + kstep; const char* b3 = b2 + kstep;
            unsigned gs0[2], gs1[2];
            if constexpr (Sched::GATHER) { gs0[0] = last ? gn0[0] : gc0[0]; gs0[1] = last ? gn0[1] : gc0[1]; gs1[0] = last ? gn1[0] : gc1[0]; gs1[1] = last ? gn1[1] : gc1[1]; }
#define PG8_VA0S (Sched::GATHER ? gs0 : voffA)
#define PG8_VA1S (Sched::GATHER ? gs1 : voffA)
            PG8_LDB(B0, 0, 0); PG8_LDB(B1, 0, 1); PG8_SCHED; PG8_LDA(At, 0, 0); PG8_STAGE(PG8_SA(1, 1), a1 + hstepA, PG8_VA1C);
            PG8_WAIT_V(8); PG8_WAIT_L(0); PG8_BAR; PG8_MMA(0, 0, At, B0); PG8_MMA(0, 1, At, B1); PG8_BAR; PG8_SCHED;
            if constexpr (!MH) PG8_LDA(At, 0, 1);
            PG8_STAGE(PG8_SB(0, 0), b2, voffB); PG8_STAGE(PG8_SB(0, 1), b2 + hstepB, voffB); PG8_STAGE(PG8_SA(0, 0), a2, PG8_VA0S);
            PG8_WAIT_V(8); PG8_WAIT_L(0); PG8_BAR; if constexpr (!MH) { PG8_MMA(1, 0, At, B0); PG8_MMA(1, 1, At, B1); } PG8_BAR; PG8_SCHED;
            PG8_LDB(B0, 1, 0); PG8_LDB(B1, 1, 1); PG8_SCHED; PG8_LDA(At, 1, 0); PG8_STAGE(PG8_SA(0, 1), a2 + hstepA, PG8_VA1S);
            PG8_WAIT_V(8); PG8_WAIT_L(0); PG8_BAR; PG8_MMA(0, 0, At, B0); PG8_MMA(0, 1, At, B1); PG8_BAR; PG8_SCHED;
            if constexpr (!MH) PG8_LDA(At, 1, 1);
            PG8_STAGE(PG8_SB(1, 0), b3, voffB); PG8_STAGE(PG8_SB(1, 1), b3 + hstepB, voffB); PG8_STAGE(PG8_SA(1, 0), a3, PG8_VA0S);
            PG8_WAIT_V(8); PG8_WAIT_L(0); PG8_BAR; if constexpr (!MH) { PG8_MMA(1, 0, At, B0); PG8_MMA(1, 1, At, B1); } PG8_BAR; PG8_SCHED;
        }
        if constexpr (MX != 0) asm volatile("s_nop 15\n\ts_nop 15" ::: "memory");
        if constexpr (ALIGN_EPI) { if (wr == 0) PG8_BAR; }
        if constexpr (!Epi::AFTER_DRAIN) E(acc, cur, wr, wc, fr, fq);
        if (!has_next) break;
        float csc = 0.f;
        if constexpr (Epi::CHAIN) csc = E.chain_scale(cur);
        if (csc == 0.f) {
#pragma unroll
            for (int a = 0; a < 2; ++a)
#pragma unroll
                for (int b = 0; b < 2; ++b)
#pragma unroll
                    for (int m = 0; m < 4; ++m)
#pragma unroll
                        for (int n = 0; n < 2; ++n) acc[a][b][m][n] = (f32x4){0.f, 0.f, 0.f, 0.f};
        } else {
#pragma unroll
            for (int a = 0; a < 2; ++a)
#pragma unroll
                for (int b = 0; b < 2; ++b)
#pragma unroll
                    for (int m = 0; m < 4; ++m)
#pragma unroll
                        for (int n = 0; n < 2; ++n) acc[a][b][m][n] = acc[a][b][m][n] * csc;
        }
        cur = nxt; cA = nA; cB = nB; ++ui;
        if constexpr (Sched::GATHER) { gc0[0] = gn0[0]; gc0[1] = gn0[1]; gc1[0] = gn1[0]; gc1[1] = gn1[1]; }
        if constexpr (ALIGN_EPI) { if (wr == 1) PG8_BAR; }
    }
    PG8_WAIT_V(0);
    if constexpr (!ALIGN_EPI) { if (wr == 0) PG8_BAR; }
    PG8_BAR;
    if constexpr (Epi::AFTER_DRAIN) E.fused(acc, cur, wr, wc, fr, fq, lds);
#undef PG8_VA0C
#undef PG8_VA1C
#undef PG8_VA0S
#undef PG8_VA1S
#undef PG8_SA
#undef PG8_SB
#undef PG8_STAGE
#undef PG8_LDA
#undef PG8_LDB
#undef PG8_MMA
#undef PG8_LDS16
#undef PG8_WAIT_V
#undef PG8_WAIT_L
#undef PG8_BAR
#undef PG8_SCHED
}
}

#define XB_TMO      128
#define XB_XCNT(j)  (256  + 64 * (j))
#define XB_XSUB(j)  (1280 + 64 * (j))
#define XB_XGEN(j)  (2304 + 64 * (j))
#define XB_TOP      3328
#define XB_TOPGEN   3392
#define XCD_BAR_WORDS 3456
#define XB_SPIN_CAP (1u << 18)
__device__ __forceinline__ unsigned xb_ld(unsigned* p)              { return __hip_atomic_load(p, __ATOMIC_RELAXED, __HIP_MEMORY_SCOPE_AGENT); }
__device__ __forceinline__ unsigned xb_add(unsigned* p, unsigned v) { return __hip_atomic_fetch_add(p, v, __ATOMIC_RELAXED, __HIP_MEMORY_SCOPE_AGENT); }
__device__ __forceinline__ unsigned xb_xcc_id() { return (unsigned)__builtin_amdgcn_s_getreg((3 << 11) | 20) & 0xFu; }
#define XB_SPIN(cond, bar) do { unsigned _sp = 0; while (cond) { __builtin_amdgcn_s_sleep(1); \
    if ((++_sp & 255u) == 0u) { if (xb_ld(&(bar)[XB_TMO])) break; if (_sp > XB_SPIN_CAP) { atomicAdd(&(bar)[XB_TMO], 1u); break; } } } } while (0)
struct XcdBarrier { unsigned* bar; unsigned x; volatile LAS unsigned* st; };
__device__ __forceinline__ XcdBarrier xcd_barrier_post(unsigned* bar, volatile LAS unsigned* st) {
    XcdBarrier b; b.bar = bar; b.x = xb_xcc_id(); b.st = st;
    if (threadIdx.x == 0) (void)xb_add(&bar[XB_XCNT(b.x)], 1u);
    return b;
}
__device__ __forceinline__ void xcd_barrier_complete(unsigned* bar, unsigned x, unsigned& nloc, unsigned& nx) {
    const unsigned G = gridDim.x * gridDim.y * gridDim.z;
    unsigned sum, cnt, mine, sp = 0u;
    for (;;) {
        sum = 0u; cnt = 0u; mine = 0u;
#pragma unroll
        for (unsigned j = 0; j < 16; ++j) { const unsigned c = xb_ld(&bar[XB_XCNT(j)]); sum += c; cnt += (c > 0u) ? 1u : 0u; mine = (j == x) ? c : mine; }
        if (sum == G) break;
        __builtin_amdgcn_s_sleep(1);
        if ((++sp & 255u) == 0u) { if (xb_ld(&bar[XB_TMO])) break; if (sp > XB_SPIN_CAP) { atomicAdd(&bar[XB_TMO], 1u); break; } }
    }
    nloc = mine > 0u ? mine : 1u; nx = cnt > 0u ? cnt : 1u;
}
__device__ __forceinline__ void xcd_barrier(const XcdBarrier& b) {
    asm volatile("s_waitcnt vmcnt(0)" ::: "memory");
    __syncthreads();
    if (threadIdx.x == 0) {
        unsigned* bar = b.bar;
        __builtin_amdgcn_s_waitcnt(0);
        unsigned nloc = b.st[0], nx = b.st[1];
        if (nloc == 0u) { xcd_barrier_complete(bar, b.x, nloc, nx); b.st[0] = nloc; b.st[1] = nx; }
        const unsigned old = xb_add(&bar[XB_XSUB(b.x)], 1u);
        const unsigned gen = old / nloc;
        if (old + 1u == (gen + 1u) * nloc) {
            __builtin_amdgcn_fence(__ATOMIC_RELEASE, "agent");
            asm volatile("s_waitcnt vmcnt(0)" ::: "memory");
            const unsigned og = xb_add(&bar[XB_TOP], 1u);
            const unsigned tg = og / nx;
            if (og + 1u == (tg + 1u) * nx) xb_add(&bar[XB_TOPGEN], 1u);
            else XB_SPIN(xb_ld(&bar[XB_TOPGEN]) == tg, bar);
            __builtin_amdgcn_fence(__ATOMIC_ACQUIRE, "agent");
            xb_add(&bar[XB_XGEN(b.x)], 1u);
            asm volatile("s_waitcnt vmcnt(0)" ::: "memory");
        } else {
            XB_SPIN(xb_ld(&bar[XB_XGEN(b.x)]) == gen, bar);
            __builtin_amdgcn_fence(__ATOMIC_ACQUIRE, "agent");
            asm volatile("s_waitcnt vmcnt(0)" ::: "memory");
        }
    }
    __syncthreads();
}

struct Params {
    const float *x, *c, *ctx, *c_ctx, *w_mod, *b_mod, *norm_mix_w, *w_in, *ret_decay_f, *ret_decay_b, *ret_gn_w, *na_rpb, *w_out, *norm_ffn_w,
                *w_rg, *b_rg, *w_re, *b_re, *w_gate, *w_up, *w_down, *final_norm_w;
    float* out; unsigned char* ws;
};

template <class RowMap>
__device__ __forceinline__ void conv_item(const float* W, int K, int N, bf16_t* WT, LAS float* scr, int kb, int nb, int lane, RowMap rm) {
    const int k0 = 64 * kb, n0 = 32 * nb;
    f32x4 v[8];
#pragma unroll
    for (int i = 0; i < 8; ++i) { const int kk = 8 * i + (lane >> 3); v[i] = __builtin_nontemporal_load((const f32x4*)(W + (size_t)(k0 + kk) * N + n0 + 4 * (lane & 7))); }
#pragma unroll
    for (int i = 0; i < 8; ++i) { const int kk = 8 * i + (lane >> 3); LAS float* d = scr + kk * 33 + 4 * (lane & 7); d[0] = v[i].x; d[1] = v[i].y; d[2] = v[i].z; d[3] = v[i].w; }
    LDS_WAIT(); asm volatile("" ::: "memory");
    const int c = lane & 7;
#pragma unroll
    for (int j = 0; j < 4; ++j) { const int n = (lane >> 3) + 8 * j; const LAS float* s = scr + (8 * c) * 33 + n;
        u32x4 o; o.x = cvt_pk_bf16(s[0 * 33], s[1 * 33]); o.y = cvt_pk_bf16(s[2 * 33], s[3 * 33]); o.z = cvt_pk_bf16(s[4 * 33], s[5 * 33]); o.w = cvt_pk_bf16(s[6 * 33], s[7 * 33]);
        __builtin_nontemporal_store(o, (u32x4*)(WT + (size_t)rm(n0 + n) * K + k0 + 8 * c)); }
    LDS_WAIT(); asm volatile("" ::: "memory");
}
template <class RowMap>
__device__ __forceinline__ void conv_item8(const float* W, int ldo, int N, unsigned char* WT, LAS float* scr, int kb, int nb, int lane, RowMap rm) {
    const int k0 = 64 * kb, n0 = 32 * nb;
    f32x4 v[8];
#pragma unroll
    for (int i = 0; i < 8; ++i) { const int kk = 8 * i + (lane >> 3); v[i] = __builtin_nontemporal_load((const f32x4*)(W + (size_t)(k0 + kk) * N + n0 + 4 * (lane & 7))); }
#pragma unroll
    for (int i = 0; i < 8; ++i) { const int kk = 8 * i + (lane >> 3); LAS float* d = scr + kk * 33 + 4 * (lane & 7); d[0] = v[i].x; d[1] = v[i].y; d[2] = v[i].z; d[3] = v[i].w; }
    LDS_WAIT(); asm volatile("" ::: "memory");
    const int c = lane & 7;
#pragma unroll
    for (int j = 0; j < 4; ++j) { const int n = (lane >> 3) + 8 * j; const LAS float* s = scr + (8 * c) * 33 + n; float h[8];
#pragma unroll
        for (int e = 0; e < 8; ++e) h[e] = s[e * 33] * W8_SCALE;
        __builtin_nontemporal_store(cvt8_fp8(h), (u32x2*)(WT + (size_t)rm(n0 + n) * ldo + k0 + 8 * c)); }
    LDS_WAIT(); asm volatile("" ::: "memory");
}
struct RmIn { __device__ __forceinline__ int operator()(int n) const { const int ct = n >> 8, f = n & 255; if (ct >= 8) return n;
        const int part = f >> 7, rem = f & 127, half = rem >> 6, i = rem & 63; return ct * 256 + half * 128 + part * 64 + i; } };
struct RmId { __device__ __forceinline__ int operator()(int n) const { return n; } };
struct RmGate { __device__ __forceinline__ int operator()(int n) const { return (n >> 7) * 256 + (n & 127); } };
struct RmUp { __device__ __forceinline__ int operator()(int n) const { return (n >> 7) * 256 + 128 + (n & 127); } };
constexpr int NCONV_IN = 7168, NCONV_OUT = 2048, NCONV_E = 16384, NCONV = NCONV_IN + NCONV_OUT + 3 * NCONV_E;
#ifndef SH3
#define SH3 21504
#endif
#ifndef A3
#define A3 30208
#endif
#ifndef A2
#define A2 4608
#endif
#ifndef A5
#define A5 6144
#endif
constexpr int CV_P3 = NCONV_IN, CV_P0 = CV_P3 + A3, CV_P2 = CV_P0 + A2, CV_P9 = CV_P2 + A5;
static_assert(CV_P9 >= NCONV_IN + NCONV_OUT + 2 * NCONV_E && CV_P9 <= NCONV, "gate/up copies must be complete before the gate/up phase");

__device__ __forceinline__ void conv_range(const Params& p, LAS unsigned char* lds, int first, int last, int worker, int nworkers, int wave, int lane) {
    LAS float* scr = (LAS float*)(lds + wave * 8448);
    bf16_t* WinT = (bf16_t*)(p.ws + WS_WIN); bf16_t* WoutT = (bf16_t*)(p.ws + WS_WOUT); unsigned char* WguT = p.ws + WS_WGU; unsigned char* WdT = p.ws + WS_WD;
    for (int it = first + worker; it < last; it += nworkers) {
        int r = it;
        if (r < NCONV_IN) { const int kb = r / 224, nb = r % 224;
            if (nb >= 128) conv_item8(p.w_in, 2 * DM, NIN, (unsigned char*)WinT, scr, kb, nb, lane, RmIn()); else conv_item(p.w_in, DM, NIN, WinT, scr, kb, nb, lane, RmIn()); continue; } r -= NCONV_IN;
        if (r < NCONV_OUT) { conv_item8(p.w_out, 2 * DM, DM, (unsigned char*)WoutT, scr, r / 64, r % 64, lane, RmId()); continue; } r -= NCONV_OUT;
        if (r < NCONV_E) { const int e = r >> 9, r2 = r & 511; conv_item8(p.w_gate + (size_t)e * DM * FF, DM, FF, WguT + (size_t)e * 1024 * DM, scr, r2 >> 4, r2 & 15, lane, RmGate()); continue; } r -= NCONV_E;
        if (r < NCONV_E) { const int e = r >> 9, r2 = r & 511; conv_item8(p.w_up + (size_t)e * DM * FF, DM, FF, WguT + (size_t)e * 1024 * DM, scr, r2 >> 4, r2 & 15, lane, RmUp()); continue; } r -= NCONV_E;
        { const int e = r >> 9, r2 = r & 511; conv_item8(p.w_down + (size_t)e * FF * DM, FF, DM, WdT + (size_t)e * DM * FF, scr, r2 >> 6, r2 & 63, lane, RmId()); }
    }
}
__device__ __forceinline__ void p0_mod_item(const Params& p, LAS unsigned char* lds, int ci, int tid, int wave, int lane) {
    LAS float* sl = (LAS float*)(lds + 69632);
    LAS float* red = (LAS float*)(lds + 69632 + 24576);
    for (int i = tid; i < 3 * 2048; i += 512) { const int r = i >> 11, k = i & 2047; const float v = (r < 2) ? p.c[r * 2048 + k] : p.c_ctx[k]; sl[i] = silu_f(v); }
    __syncthreads();
    const int rr = lane >> 4, cc = (lane & 15) * 4;
    f32x4 a0 = {0.f, 0.f, 0.f, 0.f}, a1 = a0, a2 = a0;
    const float* wp = p.w_mod + (size_t)(256 * wave + rr) * 12288 + 64 * ci + cc;
#pragma unroll 8
    for (int it = 0; it < 64; ++it) { const int k = 256 * wave + 4 * it + rr; const f32x4 wv = __builtin_nontemporal_load((const f32x4*)(wp + (size_t)(4 * it) * 12288));
        a0 += wv * sl[k]; a1 += wv * sl[2048 + k]; a2 += wv * sl[4096 + k]; }
#pragma unroll
    for (int e = 0; e < 4; ++e) { a0[e] = sum_g4(a0[e]); a1[e] = sum_g4(a1[e]); a2[e] = sum_g4(a2[e]); }
    if (lane < 16) {
#pragma unroll
        for (int e = 0; e < 4; ++e) { red[(wave * 3 + 0) * 64 + cc + e] = a0[e]; red[(wave * 3 + 1) * 64 + cc + e] = a1[e]; red[(wave * 3 + 2) * 64 + cc + e] = a2[e]; } }
    __syncthreads();
    if (tid < 192) { const int r = tid >> 6, col = tid & 63; float s = 0.f;
#pragma unroll
        for (int w = 0; w < 8; ++w) s += red[(w * 3 + r) * 64 + col];
        ((float*)(p.ws + WS_MOD))[r * 12288 + 64 * ci + col] = s + p.b_mod[64 * ci + col]; }
    asm volatile("s_waitcnt vmcnt(0)" ::: "memory");
    __syncthreads();
    if (tid == 0) { __builtin_amdgcn_fence(__ATOMIC_RELEASE, "agent"); asm volatile("s_waitcnt vmcnt(0)" ::: "memory");
        __hip_atomic_fetch_add((unsigned*)(p.ws + WS_CTL) + CW_MODRDY, 1u, __ATOMIC_RELAXED, __HIP_MEMORY_SCOPE_AGENT); }
}

__device__ __forceinline__ void p1_rows(const Params& p, int gw, int NGW, int lane) {
    const float* mod = (const float*)(p.ws + WS_MOD); bf16_t* HX = (bf16_t*)(p.ws + WS_HX); unsigned char* HX8 = p.ws + WS_X1;
    for (int row = gw; row < MALL; row += NGW) {
        const float* src = row < MTOK ? p.x + (size_t)row * DM : p.ctx + (size_t)(row - MTOK) * DM;
        const int mr = row < MTOK ? (row >> 12) : 2;
        const f32x4* xr = (const f32x4*)src + lane;
        f32x4 v[8]; float s = 0.f;
#pragma unroll
        for (int j = 0; j < 8; ++j) { v[j] = __builtin_nontemporal_load(xr + 64 * j); s += (v[j].x * v[j].x + v[j].y * v[j].y) + (v[j].z * v[j].z + v[j].w * v[j].w); }
        const float rstd = 1.0f / sqrtf(wave_sum(s) * (1.0f / DM) + NORM_EPS);
        u32x2* o8 = (u32x2*)(HX + (size_t)row * DM) + lane;
#pragma unroll
        for (int j = 0; j < 8; ++j) { const int cidx = 64 * j + lane;
            const f32x4 nw = ((const f32x4*)p.norm_mix_w)[cidx], sh = ((const f32x4*)(mod + mr * 12288))[cidx], sc = ((const f32x4*)(mod + mr * 12288 + 2048))[cidx];
            const f32x4 h = v[j] * rstd * nw * (sc + 1.0f) + sh;
            u32x2 w; w.x = cvt_pk_bf16(h.x, h.y); w.y = cvt_pk_bf16(h.z, h.w); o8[64 * j] = w;
            int q8 = __builtin_amdgcn_cvt_pk_fp8_f32(h.x, h.y, 0, false); q8 = __builtin_amdgcn_cvt_pk_fp8_f32(h.z, h.w, q8, true); *(int*)(HX8 + (size_t)row * (2 * DM) + 4 * cidx) = q8; }
    }
}

struct InProjSched {
    static constexpr bool GATHER = false, COLMAP64 = false;
    const char* hx; const char* win; int G, c;
    __device__ __forceinline__ bool next(int i, pg8::Unit& u) const {
        const int L = i * G + c; if (L >= 528) return false;
        int tt, ct, sw;
        if (L < 512) { const int x = L & 7, pos = L >> 3; tt = 4 * x + (pos & 3); const int jb = pos >> 2;
            if (jb < 12) { sw = 0; ct = jb < 8 ? jb : jb + 4; } else { sw = 1; ct = jb - 4; } }
        else { const int r = L - 512; tt = 32 + (r & 1); sw = 1; ct = 4 + (r >> 1); }
        const char* pa = hx + (size_t)tt * (256 * 2048 * 2); const char* pw = win + (size_t)ct * (256 * 2048 * 2);
        u.a = sw ? pw : pa; u.b = sw ? pa : pw; u.i0 = tt; u.i1 = ct; u.i2 = sw; u.i3 = 0; return true;
    }
};
struct InProjSched8 {
    static constexpr bool GATHER = false, COLMAP64 = true;
    const char* hx8; const char* win; int NW, w;
    __device__ __forceinline__ bool next(int i, pg8::Unit& u) const {
        if (w < 0) return false;
        const int L = i * NW + w; if (L >= 400) return false;
        int tt, ct, sw;
        if (L < 384) { tt = L & 31; const int jf = L >> 5; if (jf < 8) { sw = 0; ct = 16 + jf; } else { sw = 1; ct = 16 + jf; } }
        else { const int r = L - 384; tt = 32 + (r & 1); const int cj = r >> 1; if (cj < 4) { sw = 0; ct = 20 + cj; } else { sw = 1; ct = 20 + cj; } }
        const char* pa = hx8 + (size_t)tt * (256 * 2048 * 2); const char* pw = win + (size_t)ct * (256 * 2048 * 2);
        u.a = sw ? pw : pa; u.b = sw ? pa : pw; u.i0 = tt; u.i1 = ct; u.i2 = sw; u.i3 = 1; return true;
    }
};
__device__ __forceinline__ u32x4 dpp_ror8(u32x4 v) { u32x4 r; r.x = (unsigned)__builtin_amdgcn_mov_dpp((int)v.x, 0x128, 0xf, 0xf, false); r.y = (unsigned)__builtin_amdgcn_mov_dpp((int)v.y, 0x128, 0xf, 0xf, false);
    r.z = (unsigned)__builtin_amdgcn_mov_dpp((int)v.z, 0x128, 0xf, 0xf, false); r.w = (unsigned)__builtin_amdgcn_mov_dpp((int)v.w, 0x128, 0xf, 0xf, false); return r; }
__device__ __forceinline__ u32x4 pack8u(const f32x4 v0, const f32x4 v1) { u32x4 w; w.x = cvt_pk_bf16(v0[0], v0[1]); w.y = cvt_pk_bf16(v0[2], v0[3]); w.z = cvt_pk_bf16(v1[0], v1[1]); w.w = cvt_pk_bf16(v1[2], v1[3]); return w; }
__device__ __forceinline__ void store_pair_bf16(bf16_t* base, size_t row_stride, int fr, const u32x4 P0, const u32x4 P1) {
    const bool lo = fr < 8;
    u32x4 send; send.x = lo ? P1.x : P0.x; send.y = lo ? P1.y : P0.y; send.z = lo ? P1.z : P0.z; send.w = lo ? P1.w : P0.w;
    const u32x4 recv = dpp_ror8(send);
    u32x4 A, B; A.x = lo ? P0.x : recv.x; A.y = lo ? P0.y : recv.y; A.z = lo ? P0.z : recv.z; A.w = lo ? P0.w : recv.w;
    B.x = lo ? recv.x : P1.x; B.y = lo ? recv.y : P1.y; B.z = lo ? recv.z : P1.z; B.w = lo ? recv.w : P1.w;
    bf16_t* q = base + (size_t)(fr & 7) * row_stride + (lo ? 0 : 32);
    *(u32x4*)q = A; *(u32x4*)(q + 8 * row_stride) = B;
}
struct EpiInProj {
    static constexpr bool PERM = true, CHAIN = false, AFTER_DRAIN = false;
    unsigned char* ws; const float *decf, *decb;
    __device__ __forceinline__ void store8(bf16_t* dst, const f32x4 v0, const f32x4 v1) const {
        u32x4 w; w.x = cvt_pk_bf16(v0[0], v0[1]); w.y = cvt_pk_bf16(v0[2], v0[3]); w.z = cvt_pk_bf16(v1[0], v1[1]); w.w = cvt_pk_bf16(v1[2], v1[3]); *(u32x4*)dst = w; }
    __device__ __forceinline__ void operator()(const f32x4 (&acc)[2][2][4][2], const pg8::Unit& u, int wr, int wc, int fr, int fq) const {
        asm volatile("" : "+v"(fr), "+v"(fq));
        const int tt = u.i0, ct = u.i1, sw = u.i2, grp = ct >> 2;
        const float ROPE_C = 0.20762050593046014f;
        if (!sw) {
            const int tok0 = 256 * tt + 64 * wr + fr;
            if (grp <= 1) {
                const int h = ct & 3, part = wc >> 1, ibase = 32 * (wc & 1) + 8 * fq;
                const float scale = grp == 1 ? 0.0625f : 1.0f; bf16_t* dst = (bf16_t*)(ws + (grp == 1 ? WS_K : WS_Q));
                const float lgf = log2_sigmoid(decf[h]), lgb = log2_sigmoid(decb[h]);
                const int bb = tt >> 4, uidx = (bb * 4 + h) * 16 + (tt & 15);
                bf16_t* QP = (bf16_t*)(ws + WS_QP) + (size_t)uidx * 256 * 768;
                bf16_t* kTf = (bf16_t*)(ws + WS_KTF) + (size_t)(bb * 4 + h) * 256 * LDT + 256 + 256 * (tt & 15); bf16_t* kTb = (bf16_t*)(ws + WS_KTB) + (size_t)(bb * 4 + h) * 256 * LDT + 256 + 256 * (tt & 15);
                float inv[2][4];
#pragma unroll
                for (int n = 0; n < 2; ++n)
#pragma unroll
                    for (int e = 0; e < 4; ++e) inv[n][e] = exp2f(-(float)(ibase + 4 * n + e) * ROPE_C);
#pragma unroll
                for (int ai = 0; ai < 2; ++ai)
#pragma unroll
                    for (int m = 0; m < 4; ++m) { const int pl = 128 * ai + 64 * wr + 16 * m + fr, tok = 256 * tt + pl, ntok = tok & 4095; const float pos = (float)(part ? (ntok & 63) : (ntok >> 6));
                        f32x4 o1[2], o2[2];
#pragma unroll
                        for (int n = 0; n < 2; ++n)
#pragma unroll
                            for (int e = 0; e < 4; ++e) { float sn, cs; sincos_ang(pos * inv[n][e], sn, cs); const float x1 = acc[ai][0][m][n][e], x2 = acc[ai][1][m][n][e];
                                o1[n][e] = (x1 * cs - x2 * sn) * scale; o2[n][e] = (x1 * sn + x2 * cs) * scale; }
                        bf16_t* rowp = dst + (size_t)tok * 1024 + h * 256 + part * 128 + ibase;
                        store8(rowp, o1[0], o1[1]); store8(rowp + 64, o2[0], o2[1]);
                        if (grp == 0) {
                            const float rf = exp2f(lgf * (float)(pl + 1)), rb = exp2f(lgb * (float)(256 - pl));
                            bf16_t* qrow = QP + (size_t)pl * 768 + part * 128 + ibase;
                            store8(qrow, o1[0] * rf, o1[1] * rf); store8(qrow + 64, o2[0] * rf, o2[1] * rf);
                            store8(qrow + 256, o1[0] * rb, o1[1] * rb); store8(qrow + 256 + 64, o2[0] * rb, o2[1] * rb);
                        } else {
                            const float dfr = exp2f(lgf * (float)(255 - pl)), dbr = exp2f(lgb * (float)pl);
#pragma unroll
                            for (int n = 0; n < 2; ++n)
#pragma unroll
                                for (int e = 0; e < 4; ++e) { const int f1 = part * 128 + ibase + 4 * n + e;
                                    const unsigned w1 = cvt_pk_bf16(o1[n][e] * dfr, o1[n][e] * dbr), w2 = cvt_pk_bf16(o2[n][e] * dfr, o2[n][e] * dbr);
                                    kTf[(size_t)f1 * LDT + pl] = (bf16_t)(w1 & 0xffffu); kTb[(size_t)f1 * LDT + pl] = (bf16_t)(w1 >> 16);
                                    kTf[(size_t)(f1 + 64) * LDT + pl] = (bf16_t)(w2 & 0xffffu); kTb[(size_t)(f1 + 64) * LDT + pl] = (bf16_t)(w2 >> 16); }
                        }
                        __builtin_amdgcn_sched_barrier(0); }
            } else {
                bf16_t* dst = (bf16_t*)(ws + (grp == 3 ? WS_G : (grp == 4 ? WS_NQ : WS_NK))); const int cb = (ct & 3) * 256 + 32 * wc + 8 * fq;
                const float s8 = (grp == 4 ? 0.08838834764831845f : 1.0f) * (u.i3 ? 1.0f / W8_SCALE : 1.0f);
                if (u.i3) {
                    bf16_t* blk = dst + (size_t)(256 * tt + 64 * wr) * 1024 + (ct & 3) * 256 + 64 * wc + 8 * fq;
#pragma unroll
                    for (int ai = 0; ai < 2; ++ai)
#pragma unroll
                        for (int m = 0; m < 4; ++m) { store_pair_bf16(blk + (size_t)(128 * ai + 16 * m) * 1024, 1024, fr, pack8u(acc[ai][0][m][0] * s8, acc[ai][0][m][1] * s8), pack8u(acc[ai][1][m][0] * s8, acc[ai][1][m][1] * s8));
                            __builtin_amdgcn_sched_barrier(0); }
                } else
#pragma unroll
                for (int ai = 0; ai < 2; ++ai)
#pragma unroll
                    for (int m = 0; m < 4; ++m) { const int tok = tok0 + 128 * ai + 16 * m;
#pragma unroll
                        for (int bj = 0; bj < 2; ++bj) { f32x4 v0 = acc[ai][bj][m][0], v1 = acc[ai][bj][m][1];
                            if (grp == 3) {
#pragma unroll
                                for (int e = 0; e < 4; ++e) { v0[e] = silu_f(v0[e]); v1[e] = silu_f(v1[e]); } }
                            else { v0 = v0 * s8; v1 = v1 * s8; }
                            store8(dst + (size_t)tok * 1024 + cb + 128 * bj, v0, v1); } __builtin_amdgcn_sched_barrier(0); }
            }
        } else {
            const bool isctx = tt >= 32; const int b = isctx ? tt - 32 : (tt >> 4);
            const int tcol0 = 32 * wc + 8 * fq;
            const int colbase = isctx ? 0 : 256 + 256 * (tt & 15);
            if (grp == 1) {
                bf16_t* kTf = (bf16_t*)(ws + WS_KTF); bf16_t* kTb = (bf16_t*)(ws + WS_KTB);
                const int h = ct & 3, part = wr; const float lgf = log2_sigmoid(decf[h]), lgb = log2_sigmoid(decb[h]);
                float inv[4];
#pragma unroll
                for (int m = 0; m < 4; ++m) inv[m] = exp2f(-(float)(16 * m + fr) * ROPE_C);
#pragma unroll
                for (int bj = 0; bj < 2; ++bj) {
                    float df[2][4], db[2][4], pos[2][4];
#pragma unroll
                    for (int n = 0; n < 2; ++n)
#pragma unroll
                        for (int e = 0; e < 4; ++e) { const int tcol = 128 * bj + tcol0 + 4 * n + e; df[n][e] = exp2f(lgf * (float)(255 - tcol)) * 0.0625f; db[n][e] = exp2f(lgb * (float)tcol) * 0.0625f;
                            pos[n][e] = (float)(part ? (tcol & 63) : (4 * (tt & 15) + (tcol >> 6))); }
#pragma unroll
                    for (int m = 0; m < 4; ++m) { const int i = 16 * m + fr, f1 = part * 128 + i;
                        f32x4 o1[2], o2[2];
#pragma unroll
                        for (int n = 0; n < 2; ++n)
#pragma unroll
                            for (int e = 0; e < 4; ++e) { const float x1 = acc[0][bj][m][n][e], x2 = acc[1][bj][m][n][e]; float y1 = x1, y2 = x2;
                                if (!isctx) { float sn, cs; sincos_ang(pos[n][e] * inv[m], sn, cs); y1 = x1 * cs - x2 * sn; y2 = x1 * sn + x2 * cs; }
                                o1[n][e] = y1; o2[n][e] = y2; }
                        const size_t r1 = ((size_t)(b * 4 + h) * 256 + f1) * LDT + colbase + 128 * bj + tcol0, r2 = r1 + (size_t)64 * LDT;
                        { f32x4 t0, t1; for (int e = 0; e < 4; ++e) { t0[e] = o1[0][e] * df[0][e]; t1[e] = o1[1][e] * df[1][e]; } store8(kTf + r1, t0, t1); }
                        __builtin_amdgcn_sched_barrier(0);
                        { f32x4 t0, t1; for (int e = 0; e < 4; ++e) { t0[e] = o2[0][e] * df[0][e]; t1[e] = o2[1][e] * df[1][e]; } store8(kTf + r2, t0, t1); }
                        __builtin_amdgcn_sched_barrier(0);
                        { f32x4 t0, t1; for (int e = 0; e < 4; ++e) { t0[e] = o1[0][e] * db[0][e]; t1[e] = o1[1][e] * db[1][e]; } store8(kTb + r1, t0, t1); }
                        __builtin_amdgcn_sched_barrier(0);
                        { f32x4 t0, t1; for (int e = 0; e < 4; ++e) { t0[e] = o2[0][e] * db[0][e]; t1[e] = o2[1][e] * db[1][e]; } store8(kTb + r2, t0, t1); }
                        __builtin_amdgcn_sched_barrier(0); }
                }
            } else {
#pragma unroll
                for (int ai = 0; ai < 2; ++ai)
#pragma unroll
                    for (int m = 0; m < 4; ++m) { const int pr = 128 * ai + 64 * wr + 16 * m + fr;
                        bf16_t* rowp = (bf16_t*)(ws + WS_NVT) + ((size_t)(b * 8 + 2 * (ct & 3) + ai) * 128 + (pr & 127)) * LDT + colbase;
                        if (grp == 2) rowp = isctx ? (bf16_t*)(ws + WS_SVC) + ((size_t)(b * 4 + (ct & 3)) * 256 + pr) * 768 + 512 : (bf16_t*)(ws + WS_SV) + ((size_t)((b * 4 + (ct & 3)) * 16 + (tt & 15)) * 256 + pr) * 768 + 512;
                        if (u.i3) {
                            store_pair_bf16(rowp - (size_t)fr * LDT + 64 * wc + 8 * fq, LDT, fr, pack8u(acc[ai][0][m][0] * (1.0f / W8_SCALE), acc[ai][0][m][1] * (1.0f / W8_SCALE)), pack8u(acc[ai][1][m][0] * (1.0f / W8_SCALE), acc[ai][1][m][1] * (1.0f / W8_SCALE)));
                            __builtin_amdgcn_sched_barrier(0); continue; }
#pragma unroll
                        for (int bj = 0; bj < 2; ++bj) { const float s8 = u.i3 ? 1.0f / W8_SCALE : 1.0f; store8(rowp + 128 * bj + tcol0, acc[ai][bj][m][0] * s8, acc[ai][bj][m][1] * s8); } __builtin_amdgcn_sched_barrier(0); }
            }
        }
    }
};

struct ChainSched {
    static constexpr bool GATHER = false, COLMAP64 = false;
    const char* sv; const char* svc; const char* kT; int dir;
    __device__ __forceinline__ bool next(int i, pg8::Unit& u) const {
        if (i >= 16) return false;
        const int c = dir == 0 ? i - 1 : 16 - i;
        u.a = (i == 0) ? svc : sv + (size_t)c * (256 * 768 * 2); u.b = kT + (size_t)((i == 0) ? 0 : 256 + 256 * c) * 2;
        u.i0 = dir == 0 ? i : 15 - i; u.i1 = 0; u.i2 = 0; u.i3 = 0; return true;
    }
};
struct EpiChain {
    static constexpr bool PERM = true, CHAIN = true, AFTER_DRAIN = false;
    bf16_t* SVbh; int dir; float cdec;
    __device__ __forceinline__ float chain_scale(const pg8::Unit&) const { return cdec; }
    __device__ __forceinline__ void operator()(const f32x4 (&acc)[2][2][4][2], const pg8::Unit& u, int wr, int wc, int fr, int fq) const {
        asm volatile("" : "+v"(fr), "+v"(fq));
        bf16_t* base = SVbh + (size_t)u.i0 * (256 * 768) + dir * 256;
        constexpr int ai = 0;
#pragma unroll
            for (int m = 0; m < 4; ++m) { bf16_t* rowp = base + (size_t)(64 * wr + 16 * m + fr) * 768 + 32 * wc + 8 * fq;
#pragma unroll
                for (int bj = 0; bj < 2; ++bj) { const f32x4 v0 = acc[ai][bj][m][0], v1 = acc[ai][bj][m][1];
                    u32x4 w; w.x = cvt_pk_bf16(v0[0], v0[1]); w.y = cvt_pk_bf16(v0[2], v0[3]); w.z = cvt_pk_bf16(v1[0], v1[1]); w.w = cvt_pk_bf16(v1[2], v1[3]); *(u32x4*)(rowp + 128 * bj) = w; } }
    }
};
struct ScoreSched {
    static constexpr bool GATHER = false, COLMAP64 = false;
    const char* q; const char* k; int unit;
    __device__ __forceinline__ bool next(int i, pg8::Unit& u) const {
        if (i > 0 || unit < 0) return false;
        const int c = unit & 15, h = (unit >> 4) & 3, b = unit >> 6; const size_t off = ((size_t)(b * 4096 + 256 * c) * 1024 + h * 256) * 2;
        u.a = q + off; u.b = k + off; u.i0 = unit; u.i1 = h; u.i2 = 0; u.i3 = 0; return true;
    }
};
struct EpiScore {
    static constexpr bool PERM = true, CHAIN = false, AFTER_DRAIN = false;
    bf16_t* QP; const float *decf, *decb;
    __device__ __forceinline__ void operator()(const f32x4 (&acc)[2][2][4][2], const pg8::Unit& u, int wr, int wc, int fr, int fq) const {
        asm volatile("" : "+v"(fr), "+v"(fq));
        const float lgf = log2_sigmoid(decf[u.i1]), lgb = log2_sigmoid(decb[u.i1]);
        bf16_t* base = QP + (size_t)u.i0 * (256 * 768) + 512;
#pragma unroll
        for (int ai = 0; ai < 2; ++ai)
#pragma unroll
            for (int m = 0; m < 4; ++m) { const int i = 128 * ai + 64 * wr + 16 * m + fr;
#pragma unroll
                for (int bj = 0; bj < 2; ++bj) { const int j0 = 128 * bj + 32 * wc + 8 * fq; f32x4 v[2];
#pragma unroll
                    for (int n = 0; n < 2; ++n)
#pragma unroll
                        for (int e = 0; e < 4; ++e) { const int d = i - (j0 + 4 * n + e); const float D = d > 0 ? exp2f(lgf * (float)d) : (d < 0 ? exp2f(lgb * (float)(-d)) : 2.0f); v[n][e] = acc[ai][bj][m][n][e] * D; }
                    u32x4 w; w.x = cvt_pk_bf16(v[0][0], v[0][1]); w.y = cvt_pk_bf16(v[0][2], v[0][3]); w.z = cvt_pk_bf16(v[1][0], v[1][1]); w.w = cvt_pk_bf16(v[1][2], v[1][3]);
                    *(u32x4*)(base + (size_t)i * 768 + j0) = w; }
                __builtin_amdgcn_sched_barrier(0); }
    }
};
struct RetOutSched {
    static constexpr bool GATHER = false, COLMAP64 = false;
    const char* qp; const char* sv; int unit;
    __device__ __forceinline__ bool next(int i, pg8::Unit& u) const {
        if (i > 0 || unit < 0) return false;
        u.a = qp + (size_t)unit * (256 * 768 * 2); u.b = sv + (size_t)unit * (256 * 768 * 2); u.i0 = unit; u.i1 = 0; u.i2 = 0; u.i3 = 0; return true;
    }
};
struct EpiRetOut {
    static constexpr bool PERM = true, CHAIN = false, AFTER_DRAIN = true;
    const bf16_t* G; const float* gnw; bf16_t* MIX;
    __device__ __forceinline__ void operator()(const f32x4 (&)[2][2][4][2], const pg8::Unit&, int, int, int, int) const {}
    __device__ __forceinline__ void fused(const f32x4 (&acc)[2][2][4][2], const pg8::Unit& u, int wr, int wc, int fr, int fq, LAS unsigned char* lds) const {
        asm volatile("" : "+v"(fr), "+v"(fq));
        const int unit = u.i0, c = unit & 15, h = (unit >> 4) & 3, b = unit >> 6;
        LAS f32x2* Pst = (LAS f32x2*)lds;
#pragma unroll
        for (int ai = 0; ai < 2; ++ai)
#pragma unroll
            for (int m = 0; m < 4; ++m) { float s = 0.f, q = 0.f;
#pragma unroll
                for (int bj = 0; bj < 2; ++bj)
#pragma unroll
                    for (int n = 0; n < 2; ++n) { const f32x4 x = acc[ai][bj][m][n]; s += (x[0] + x[1]) + (x[2] + x[3]); q += (x[0] * x[0] + x[1] * x[1]) + (x[2] * x[2] + x[3] * x[3]); }
                s = sum_g4(s); q = sum_g4(q);
                if (fq == 0) Pst[(128 * ai + 64 * wr + 16 * m + fr) * 4 + wc] = (f32x2){s, q}; }
        asm volatile("s_waitcnt lgkmcnt(0)" ::: "memory"); __builtin_amdgcn_s_barrier(); asm volatile("" ::: "memory");
        f32x4 gw0[2], gw1[2];
#pragma unroll
        for (int bj = 0; bj < 2; ++bj) { const int v0 = h * 256 + 128 * bj + 32 * wc + 8 * fq; gw0[bj] = *(const f32x4*)(gnw + v0); gw1[bj] = *(const f32x4*)(gnw + v0 + 4); }
#pragma unroll
        for (int ai = 0; ai < 2; ++ai) {
            u32x4 gg[4][2];
#pragma unroll
            for (int m = 0; m < 4; ++m) { const size_t tok = (size_t)b * 4096 + 256 * c + 128 * ai + 64 * wr + 16 * m + fr;
#pragma unroll
                for (int bj = 0; bj < 2; ++bj) gg[m][bj] = *(const u32x4*)(G + tok * 1024 + h * 256 + 128 * bj + 32 * wc + 8 * fq); }
#pragma unroll
            for (int m = 0; m < 4; ++m) { const int r = 128 * ai + 64 * wr + 16 * m + fr;
                const f32x2 p0 = Pst[r * 4 + 0], p1 = Pst[r * 4 + 1], p2 = Pst[r * 4 + 2], p3 = Pst[r * 4 + 3];
                const float mu = ((p0.x + p1.x) + (p2.x + p3.x)) * (1.0f / 256.0f); const float ex2 = ((p0.y + p1.y) + (p2.y + p3.y)) * (1.0f / 256.0f);
                const float rstd = 1.0f / sqrtf(fmaxf(ex2 - mu * mu, 0.f) + NORM_EPS);
                const size_t tok = (size_t)b * 4096 + 256 * c + r;
#pragma unroll
                for (int bj = 0; bj < 2; ++bj) { const int v0 = h * 256 + 128 * bj + 32 * wc + 8 * fq; const u32x4 g4 = gg[m][bj];
                    const f32x4 y0 = (acc[ai][bj][m][0] - mu) * rstd * gw0[bj], y1 = (acc[ai][bj][m][1] - mu) * rstd * gw1[bj];
                    float h8[8] = {y0[0] * bflo(g4.x) * MIX8_SCALE, y0[1] * bfhi(g4.x) * MIX8_SCALE, y0[2] * bflo(g4.y) * MIX8_SCALE, y0[3] * bfhi(g4.y) * MIX8_SCALE,
                                   y1[0] * bflo(g4.z) * MIX8_SCALE, y1[1] * bfhi(g4.z) * MIX8_SCALE, y1[2] * bflo(g4.w) * MIX8_SCALE, y1[3] * bfhi(g4.w) * MIX8_SCALE};
                    *(u32x2*)((unsigned char*)MIX + tok * 4096 + v0) = cvt8_fp8(h8); } }
        }
    }
};

__device__ __forceinline__ bf16x8 pack8(const f32x4 a, const f32x4 b) {
    u32x4 w; w.x = cvt_pk_bf16(a[0], a[1]); w.y = cvt_pk_bf16(a[2], a[3]); w.z = cvt_pk_bf16(b[0], b[1]); w.w = cvt_pk_bf16(b[2], b[3]); return __builtin_bit_cast(bf16x8, w); }
__device__ __forceinline__ bf16x8 ld44(const bf16_t* p0) { const s16x4 lo = *(const s16x4*)p0, hi = *(const s16x4*)(p0 + 16); bf16x8 r; r[0] = lo[0]; r[1] = lo[1]; r[2] = lo[2]; r[3] = lo[3]; r[4] = hi[0]; r[5] = hi[1]; r[6] = hi[2]; r[7] = hi[3]; return r; }

__device__ __forceinline__ void na_item(const Params& p, int it, int lane) {
    asm volatile("" : "+v"(lane));
    const bf16_t* NQ = (const bf16_t*)(p.ws + WS_NQ); const bf16_t* NK = (const bf16_t*)(p.ws + WS_NK); const bf16_t* NVT = (const bf16_t*)(p.ws + WS_NVT); bf16_t* MIX = (bf16_t*)(p.ws + WS_MIX);
    const int qb = it & 3, r = (it >> 2) & 63, nh = (it >> 8) & 7, b = it >> 11;
    const int l15 = lane & 15, g = lane >> 4;
    const int rs = min(max(r - 4, 0), 56), c0 = min(max(16 * qb - 8, 0), 32);
    const int qc = 16 * qb + l15; const size_t tq = (size_t)b * 4096 + r * 64 + qc;
    bf16x8 bq[4];
#pragma unroll
    for (int ks = 0; ks < 4; ++ks) bq[ks] = *(const bf16x8*)(NQ + tq * 1024 + nh * 128 + 32 * ks + 8 * g);
    f32x4 s[32];
#pragma unroll
    for (int f = 0; f < 32; ++f) {
        size_t kt;
        if (f < 16) kt = (size_t)b * 4096 + (rs + (f >> 1)) * 64 + c0 + 16 * (f & 1) + l15; else kt = (size_t)MTOK + b * 256 + 16 * (f - 16) + l15;
        const bf16_t* kp = NK + kt * 1024 + nh * 128 + 8 * g;
        f32x4 a = {0.f, 0.f, 0.f, 0.f};
#pragma unroll
        for (int ks = 0; ks < 4; ++ks) a = __builtin_amdgcn_mfma_f32_16x16x32_bf16(*(const bf16x8*)(kp + 32 * ks), bq[ks], a, 0, 0, 0);
        s[f] = a;
    }
    const int cs = min(max(qc - 8, 0), 48);
    const float* rp = p.na_rpb + nh * 15 * 31;
    float mx = -1e30f;
#pragma unroll
    for (int f = 0; f < 16; ++f) { const int kr = f >> 1; const float* rrow = rp + (rs + kr - r + 7) * 31;
#pragma unroll
        for (int j = 0; j < 4; ++j) { const int kc = c0 + 16 * (f & 1) + 4 * g + j; const bool valid = (kc >= cs) && (kc < cs + 16);
            float v = -1e30f; if (valid) v = s[f][j] + rrow[kc - qc + 15]; s[f][j] = v; mx = fmaxf(mx, v); } }
#pragma unroll
    for (int f = 16; f < 32; ++f)
#pragma unroll
        for (int j = 0; j < 4; ++j) mx = fmaxf(mx, s[f][j]);
    mx = max_g4(mx);
    float l = 0.f;
#pragma unroll
    for (int f = 0; f < 32; ++f)
#pragma unroll
        for (int j = 0; j < 4; ++j) { const float v = s[f][j]; const float e = (v <= -1e29f) ? 0.f : exp2f((v - mx) * LOG2E); s[f][j] = e; l += e; }
    l = sum_g4(l);
    f32x4 o[8];
#pragma unroll
    for (int df = 0; df < 8; ++df) o[df] = (f32x4){0.f, 0.f, 0.f, 0.f};
#pragma unroll
    for (int t = 0; t < 16; ++t) {
        const bf16x8 pb = pack8(s[2 * t], s[2 * t + 1]);
        const int col = (t < 8) ? 256 + (rs + t) * 64 + c0 + 4 * g : 32 * (t - 8) + 4 * g;
#pragma unroll
        for (int df = 0; df < 8; ++df) { const bf16_t* vp = NVT + ((size_t)(b * 8 + nh) * 128 + 16 * df + l15) * LDT + col;
            o[df] = __builtin_amdgcn_mfma_f32_16x16x32_bf16(ld44(vp), pb, o[df], 0, 0, 0); }
    }
    const float inv = 1.0f / l;
#pragma unroll
    for (int df = 0; df < 8; ++df) { u32x2 w; w.x = cvt_pk_bf16(o[df][0] * inv, o[df][1] * inv); w.y = cvt_pk_bf16(o[df][2] * inv, o[df][3] * inv);
        *(u32x2*)(MIX + tq * 2048 + 1024 + nh * 128 + 16 * df + 4 * g) = w; }
}


__device__ __forceinline__ void na_wg_items(const Params& p, LAS unsigned char* lds, int item, const int item_end, const int stride, int wave, int lane) {
    if (item >= item_end) return;
    const bf16_t* NQ = (const bf16_t*)(p.ws + WS_NQ); const bf16_t* NK = (const bf16_t*)(p.ws + WS_NK); const bf16_t* NVT = (const bf16_t*)(p.ws + WS_NVT); bf16_t* MIX = (bf16_t*)(p.ws + WS_MIX);
    LAS float* mxs = (LAS float*)(lds + 148480);
    LAS float* sms = mxs + 128;
    LAS float* rpbs = (LAS float*)(lds + 150528);
    LAS unsigned char* xo = lds + 98304;
#define NA_DMAK(s, buf, B_, RS_, NH_) do { _Pragma("unroll") for (int i = 0; i < 6; ++i) { const int q = wave + 8 * i, row = 4 * q + (lane >> 4), c = (lane & 15) ^ (row & 15); \
        const size_t trow = (i < 4) ? (size_t)(B_) * 4096 + ((RS_) + 2 * (s) + (row >> 6)) * 64 + (row & 63) : (size_t)MTOK + (B_) * 256 + 64 * (s) + (row - 128); \
        __builtin_amdgcn_global_load_lds((const unsigned*)(NK + trow * 1024 + (NH_) * 128 + 8 * c), (LAS unsigned*)((buf) + q * 1024), 16, 0, 0); } } while (0)
#define NA_DMAV(s, buf) do { _Pragma("unroll") for (int i = 0; i < 6; ++i) { \
        if (i < 4) { const int q = wave + 8 * i, d = 4 * q + (lane >> 4), c = (lane & 15) ^ (d & 15); \
            __builtin_amdgcn_global_load_lds((const unsigned*)(nvrow + (size_t)d * LDT + 256 + (rs + 2 * (s)) * 64 + 8 * c), (LAS unsigned*)((buf) + q * 1024), 16, 0, 0); } \
        else { const int q2 = wave + 8 * (i - 4), d = 8 * q2 + (lane >> 3), c = (lane & 7) ^ (d & 7); \
            __builtin_amdgcn_global_load_lds((const unsigned*)(nvrow + (size_t)d * LDT + 64 * (s) + 8 * c), (LAS unsigned*)((buf) + 32768 + q2 * 1024), 16, 0, 0); } } } while (0)
#define NA_BUF(gst) (lds + ((gst) % 3) * 49152)
#define NA_SYNC(n) do { asm volatile("s_waitcnt vmcnt(" #n ") lgkmcnt(0)" ::: "memory"); __builtin_amdgcn_s_barrier(); asm volatile("" ::: "memory"); } while (0)
#define NA_SYNCL() do { asm volatile("s_waitcnt lgkmcnt(0)" ::: "memory"); __builtin_amdgcn_s_barrier(); asm volatile("" ::: "memory"); } while (0)
    bf16x8 bq[4]; float rpbv = 0.f;
    { asm volatile("" : "+v"(lane));
      const int r = item & 63, nh = (item >> 6) & 7, b = item >> 9, l15 = lane & 15, g = lane >> 4, qb = wave & 3, tid = wave * 64 + lane;
      const int rs = min(max(r - 4, 0), 56); const size_t tq = (size_t)b * 4096 + r * 64 + 16 * qb + l15;
      NA_DMAK(0, NA_BUF(0), b, rs, nh);
#pragma unroll
      for (int ks = 0; ks < 4; ++ks) bq[ks] = *(const bf16x8*)(NQ + tq * 1024 + nh * 128 + 32 * ks + 8 * g);
      if (tid < 465) rpbv = p.na_rpb[nh * 465 + tid]; }
#pragma unroll 1
    for (;;) {
    asm volatile("" : "+v"(lane));
    const int nitem = item + stride; const bool has_next = nitem < item_end;
    const int r = item & 63, nh = (item >> 6) & 7, b = item >> 9;
    const int tid = wave * 64 + lane, l15 = lane & 15, g = lane >> 4, qb = wave & 3, half = wave >> 2;
    const int rs = min(max(r - 4, 0), 56), c0 = min(max(16 * qb - 8, 0), 32);
    const int qc = 16 * qb + l15; const size_t tq = (size_t)b * 4096 + r * 64 + qc;
    const bf16_t* nvrow = NVT + (size_t)(b * 8 + nh) * 128 * LDT;
    f32x4 sf[16];
    NA_DMAK(1, NA_BUF(1), b, rs, nh);
    asm volatile("s_waitcnt vmcnt(6)" : "+v"(rpbv), "+v"(bq[0]), "+v"(bq[1]), "+v"(bq[2]), "+v"(bq[3]) :: "memory");
    if (tid < 465) rpbs[tid] = rpbv;
    NA_SYNC(6);
#pragma unroll
    for (int s = 0; s < 4; ++s) {
        LAS unsigned char* cur = NA_BUF(s);
        if (s == 0) NA_DMAK(2, NA_BUF(2), b, rs, nh); else if (s == 1) NA_DMAK(3, NA_BUF(3), b, rs, nh); else if (s == 2) NA_DMAV(0, NA_BUF(4)); else NA_DMAV(1, NA_BUF(5));
#pragma unroll
        for (int fi = 0; fi < 4; ++fi) { const int row = half ? 128 + 16 * fi + l15 : (fi >> 1) * 64 + c0 + 16 * (fi & 1) + l15;
            f32x4 a = {0.f, 0.f, 0.f, 0.f};
#pragma unroll
            for (int ks = 0; ks < 4; ++ks) a = __builtin_amdgcn_mfma_f32_16x16x32_bf16(*(const LAS bf16x8*)(cur + row * 256 + (((4 * ks + g) ^ (row & 15)) << 4)), bq[ks], a, 0, 0, 0);
            sf[4 * s + fi] = a; }
        NA_SYNC(6);
    }
    float mx = -1e30f;
    if (!half) {
        const int cs = min(max(qc - 8, 0), 48);
#pragma unroll
        for (int f = 0; f < 16; ++f) { const int kr = f >> 1; const LAS float* rrow = rpbs + (rs + kr - r + 7) * 31 - qc + 15;
#pragma unroll
            for (int j = 0; j < 4; ++j) { const int kc = c0 + 16 * (f & 1) + 4 * g + j; const bool valid = (kc >= cs) && (kc < cs + 16);
                float v = -1e30f; if (valid) v = sf[f][j] + rrow[kc]; sf[f][j] = v; mx = fmaxf(mx, v); } }
    } else {
#pragma unroll
        for (int f = 0; f < 16; ++f)
#pragma unroll
            for (int j = 0; j < 4; ++j) mx = fmaxf(mx, sf[f][j]);
    }
    mx = max_g4(mx);
    if (g == 0) mxs[half * 64 + qc] = mx;
    NA_SYNC(6);
    mx = fmaxf(mxs[qc], mxs[64 + qc]) * LOG2E;
    float l = 0.f;
#pragma unroll
    for (int f = 0; f < 16; ++f)
#pragma unroll
        for (int j = 0; j < 4; ++j) { const float v = sf[f][j]; const float e = (v <= -1e29f) ? 0.f : __builtin_amdgcn_exp2f(v * LOG2E - mx); sf[f][j] = e; l += e; }
    l = sum_g4(l);
    if (g == 0) sms[half * 64 + qc] = l;
    bf16x8 pb[8];
#pragma unroll
    for (int t = 0; t < 8; ++t) pb[t] = pack8(sf[2 * t], sf[2 * t + 1]);
    f32x4 o[8];
#pragma unroll
    for (int df = 0; df < 8; ++df) o[df] = (f32x4){0.f, 0.f, 0.f, 0.f};
    const int vbase = half ? 32768 : 0, vstride = half ? 128 : 256, vsw = l15 & (half ? 7 : 15);
#pragma unroll
    for (int s = 0; s < 4; ++s) {
        LAS unsigned char* cur = NA_BUF(s + 4);
        if (s == 0) NA_DMAV(2, NA_BUF(6)); else if (s == 1) NA_DMAV(3, NA_BUF(7));
        if (s == 3 && has_next) {
            const int rn = nitem & 63, nhn = (nitem >> 6) & 7, bn = nitem >> 9, rsn = min(max(rn - 4, 0), 56); const size_t tqn = (size_t)bn * 4096 + rn * 64 + qc;
            NA_DMAK(0, NA_BUF(0), bn, rsn, nhn);
#pragma unroll
            for (int ks = 0; ks < 4; ++ks) bq[ks] = *(const bf16x8*)(NQ + tqn * 1024 + nhn * 128 + 32 * ks + 8 * g);
            if (tid < 465) rpbv = p.na_rpb[nhn * 465 + tid]; }
#pragma unroll
        for (int k2 = 0; k2 < 2; ++k2) { const int ch0 = (half ? 4 * k2 : 8 * k2 + (c0 >> 3)) + (g >> 1);
#pragma unroll
            for (int df = 0; df < 8; ++df) { const LAS unsigned char* rowp = cur + vbase + (16 * df + l15) * vstride + 8 * (g & 1);
                const s16x4 lo = *(const LAS s16x4*)(rowp + ((ch0 ^ vsw) << 4)), hi = *(const LAS s16x4*)(rowp + (((ch0 + 2) ^ vsw) << 4));
                bf16x8 a; a[0] = lo[0]; a[1] = lo[1]; a[2] = lo[2]; a[3] = lo[3]; a[4] = hi[0]; a[5] = hi[1]; a[6] = hi[2]; a[7] = hi[3];
                o[df] = __builtin_amdgcn_mfma_f32_16x16x32_bf16(a, pb[2 * s + k2], o[df], 0, 0, 0); } }
        if (s == 3 && half) {
#pragma unroll
            for (int df = 0; df < 8; ++df) *(LAS f32x4*)(xo + ((qb * 8 + df) * 64 + lane) * 16) = o[df]; }
        if (s < 2) NA_SYNC(6); else if (s == 2) NA_SYNC(0); else NA_SYNCL();
    }
    if (!half) {
        const float inv = 1.0f / (sms[qc] + sms[64 + qc]);
#pragma unroll
        for (int df = 0; df < 8; ++df) { const f32x4 oc = *(const LAS f32x4*)(xo + ((qb * 8 + df) * 64 + lane) * 16); const f32x4 t = (o[df] + oc) * (inv * MIX8_SCALE);
            int q8 = __builtin_amdgcn_cvt_pk_fp8_f32(t[0], t[1], 0, false); q8 = __builtin_amdgcn_cvt_pk_fp8_f32(t[2], t[3], q8, true);
            *(int*)((unsigned char*)MIX + tq * 4096 + 1024 + nh * 128 + 16 * df + 4 * g) = q8; }
    }
    NA_SYNCL();
    if (!has_next) break;
    item = nitem;
    }
    asm volatile("s_waitcnt vmcnt(0)" ::: "memory");
#undef NA_BUF
#undef NA_DMAK
#undef NA_DMAV
#undef NA_SYNC
#undef NA_SYNCL
}

struct OutProjSched {
    static constexpr bool GATHER = false, COLMAP64 = false;
    const char* mix; const char* wout; int G, c;
    __device__ __forceinline__ bool next(int i, pg8::Unit& u) const {
        const int L = i * G + c; if (L >= 256) return false;
        const int x = L & 7, pos = L >> 3, tt = 4 * x + (pos & 3), nt = pos >> 2;
        u.a = mix + (size_t)tt * (256 * 2048 * 2); u.b = wout + (size_t)nt * (256 * 2048 * 2); u.i0 = tt; u.i1 = nt; u.i2 = 0; u.i3 = 0; return true;
    }
};
struct EpiOutProj {
    static constexpr bool PERM = true, CHAIN = false, AFTER_DRAIN = false;
    const float* x; const float* mod; bf16_t* x1;
    __device__ __forceinline__ void operator()(const f32x4 (&acc)[2][2][4][2], const pg8::Unit& u, int wr, int wc, int fr, int fq) const {
        asm volatile("" : "+v"(fr), "+v"(fq));
        const int tt = u.i0, b = tt >> 4; const int col0 = 256 * u.i1 + 32 * wc + 8 * fq;
        const float* ga = mod + b * 12288 + 2 * 2048;
        f32x4 gv[2][2];
#pragma unroll
        for (int bj = 0; bj < 2; ++bj) { gv[bj][0] = *(const f32x4*)(ga + col0 + 128 * bj) * (1.0f / (W8_SCALE * MIX8_SCALE)); gv[bj][1] = *(const f32x4*)(ga + col0 + 128 * bj + 4) * (1.0f / (W8_SCALE * MIX8_SCALE)); }
#pragma unroll
        for (int am = 0; am < 4; ++am) { const int ai = am >> 1, mb = 2 * (am & 1);
            f32x4 xv[2][2][2];
#pragma unroll
            for (int m = 0; m < 2; ++m) { const size_t off = (size_t)(256 * tt + 128 * ai + 64 * wr + 16 * (mb + m) + fr) * DM + col0;
#pragma unroll
                for (int bj = 0; bj < 2; ++bj) { xv[m][bj][0] = __builtin_nontemporal_load((const f32x4*)(x + off + 128 * bj)); xv[m][bj][1] = __builtin_nontemporal_load((const f32x4*)(x + off + 128 * bj + 4)); } }
#pragma unroll
            for (int m = 0; m < 2; ++m) { const size_t off = (size_t)(256 * tt + 128 * ai + 64 * wr + 16 * (mb + m) + fr) * DM + col0;
#pragma unroll
                for (int bj = 0; bj < 2; ++bj) { const f32x4 r0 = xv[m][bj][0] + gv[bj][0] * acc[ai][bj][mb + m][0], r1 = xv[m][bj][1] + gv[bj][1] * acc[ai][bj][mb + m][1];
                    u32x4 w; w.x = cvt_pk_bf16(r0[0], r0[1]); w.y = cvt_pk_bf16(r0[2], r0[3]); w.z = cvt_pk_bf16(r1[0], r1[1]); w.w = cvt_pk_bf16(r1[2], r1[3]);
                    *(u32x4*)(x1 + off + 128 * bj) = w; } }
        }
    }
};

constexpr int P7_LD = 2050;
__device__ __forceinline__ void p7_item(const Params& p, LAS unsigned char* lds, int item, int slot, int tid, int wave, int lane) {
    const float* mod = (const float*)(p.ws + WS_MOD); const bf16_t* X1 = (const bf16_t*)(p.ws + WS_X1); unsigned char* HF = p.ws + WS_HF;
    LAS float* hfs = (LAS float*)lds;
    LAS float* red = (LAS float*)(lds + 131584);
    const int row0 = item * 16;
    {
        u32x4 raw[2][4];
#pragma unroll
        for (int rr = 0; rr < 2; ++rr)
#pragma unroll
            for (int j = 0; j < 4; ++j) raw[rr][j] = ((const u32x4*)(X1 + (size_t)(row0 + 2 * wave + rr) * DM))[64 * j + lane];
#pragma unroll
        for (int rr = 0; rr < 2; ++rr) {
            const int li = 2 * wave + rr, row = row0 + li, b = row >> 12;
            float v[4][8]; float s = 0.f;
#pragma unroll
            for (int j = 0; j < 4; ++j) { const u32x4 w = raw[rr][j];
                v[j][0] = bflo(w.x); v[j][1] = bfhi(w.x); v[j][2] = bflo(w.y); v[j][3] = bfhi(w.y); v[j][4] = bflo(w.z); v[j][5] = bfhi(w.z); v[j][6] = bflo(w.w); v[j][7] = bfhi(w.w);
#pragma unroll
                for (int e = 0; e < 8; ++e) s += v[j][e] * v[j][e]; }
            const float rstd = 1.0f / sqrtf(wave_sum(s) * (1.0f / DM) + NORM_EPS);
            u32x2* o8 = (u32x2*)(HF + (size_t)row * DM) + lane;
#pragma unroll
            for (int j = 0; j < 4; ++j) { const int c8 = 2 * (64 * j + lane);
                float h[8];
#pragma unroll
                for (int q = 0; q < 2; ++q) { const f32x4 nw = ((const f32x4*)p.norm_ffn_w)[c8 + q], sh = ((const f32x4*)(mod + b * 12288 + 3 * 2048))[c8 + q], sc = ((const f32x4*)(mod + b * 12288 + 4 * 2048))[c8 + q];
#pragma unroll
                    for (int e = 0; e < 4; ++e) h[4 * q + e] = v[j][4 * q + e] * rstd * nw[e] * (sc[e] + 1.0f) + sh[e]; }
                o8[64 * j] = cvt8_fp8(h);
                LAS f32x2* d = (LAS f32x2*)(hfs + li * P7_LD + 4 * c8); d[0] = (f32x2){h[0], h[1]}; d[1] = (f32x2){h[2], h[3]}; d[2] = (f32x2){h[4], h[5]}; d[3] = (f32x2){h[6], h[7]}; }
        }
    }
    __syncthreads();
    {
        const int i = lane & 15, kq = lane >> 4, k0 = 256 * wave + 32 * kq;
        const float* WrT = (const float*)(p.ws + WS_WRT);
        const float* w0 = WrT + (size_t)i * DM + k0; const float* w1 = WrT + (size_t)(16 + i) * DM + k0; const float* w2 = WrT + (size_t)(32 + i) * DM + k0;
        const LAS float* ap = hfs + i * P7_LD + k0;
        f32x4 a0 = {0.f, 0.f, 0.f, 0.f}, a1 = a0, a2 = a0;
#pragma unroll
        for (int blk = 0; blk < 4; ++blk) { const int ko = 128 * (blk >> 1) + 16 * (blk & 1);
            f32x4 b0[4], b1[4], b2[4]; f32x2 av[8];
#pragma unroll
            for (int q = 0; q < 4; ++q) { b0[q] = *(const f32x4*)(w0 + ko + 4 * q); b1[q] = *(const f32x4*)(w1 + ko + 4 * q); b2[q] = *(const f32x4*)(w2 + ko + 4 * q); }
#pragma unroll
            for (int q = 0; q < 8; ++q) av[q] = *(const LAS f32x2*)(ap + ko + 2 * q);
#pragma unroll
            for (int q = 0; q < 4; ++q)
#pragma unroll
                for (int e = 0; e < 4; ++e) { const float a = av[2 * q + (e >> 1)][e & 1];
                    a0 = __builtin_amdgcn_mfma_f32_16x16x4f32(a, b0[q][e], a0, 0, 0, 0);
                    a1 = __builtin_amdgcn_mfma_f32_16x16x4f32(a, b1[q][e], a1, 0, 0, 0);
                    a2 = __builtin_amdgcn_mfma_f32_16x16x4f32(a, b2[q][e], a2, 0, 0, 0); }
        }
        LAS f32x4* rw = (LAS f32x4*)red + (wave * 3) * 64 + lane; rw[0] = a0; rw[64] = a1; rw[128] = a2;
    }
    __syncthreads();
    if (tid < 256) {
        const int i = tid >> 4, n = tid & 15, src_lane = (i >> 2) * 16 + n, j = i & 3;
        LAS float* lgs = (LAS float*)(lds + 156160) + (slot * 16 + i) * 36;
#pragma unroll
        for (int tl = 0; tl < 3; ++tl) { float s = 0.f;
#pragma unroll
            for (int w = 0; w < 8; ++w) s += red[((w * 3 + tl) * 64 + src_lane) * 4 + j];
            if (tl == 0) { if (n < 4) lgs[n] = s; } else lgs[4 + (tl - 1) * 16 + n] = s; }
    }
}
__device__ __forceinline__ void p7_finish(const Params& p, LAS unsigned char* lds, int row_first, int row_stride, int nrows, int tid, int cnt_off) {
    unsigned* tok = (unsigned*)(p.ws + WS_TOK); unsigned* cnt = (unsigned*)(p.ws + WS_CTL) + CW_CNT + cnt_off;
    const LAS float* lgs = (const LAS float*)(lds + 156160); LAS unsigned* lcnt = (LAS unsigned*)(lds + 156160 + 4608); LAS unsigned* lbase = lcnt + 32;
    __syncthreads();
    int e0 = 0, e1 = 0; unsigned r0 = 0u, r1 = 0u; float w0 = 0.f, w1 = 0.f;
    if (tid < nrows) {
        const LAS float* L = lgs + tid * 36;
        float gl[4];
#pragma unroll
        for (int q = 0; q < 4; ++q) gl[q] = L[q] + p.b_rg[q];
        int gsel = 0; float gmax = gl[0];
#pragma unroll
        for (int q = 1; q < 4; ++q) if (gl[q] > gmax) { gmax = gl[q]; gsel = q; }
        float gden = 0.f;
#pragma unroll
        for (int q = 0; q < 4; ++q) gden += __expf(gl[q] - gmax);
        const float gwt = 1.0f / gden;
        float el[8];
#pragma unroll
        for (int q = 0; q < 8; ++q) el[q] = L[4 + gsel * 8 + q] + p.b_re[gsel * 8 + q];
        int i0 = 0; float v0 = el[0];
#pragma unroll
        for (int q = 1; q < 8; ++q) if (el[q] > v0) { v0 = el[q]; i0 = q; }
        int i1 = -1; float v1 = -3.0e38f;
#pragma unroll
        for (int q = 0; q < 8; ++q) if (q != i0 && el[q] > v1) { v1 = el[q]; i1 = q; }
        const float ex = __expf(v1 - v0); w0 = gwt / (1.0f + ex); w1 = gwt * ex / (1.0f + ex);
        e0 = gsel * 8 + i0; e1 = gsel * 8 + i1;
        r0 = __hip_atomic_fetch_add(lcnt + e0, 1u, __ATOMIC_RELAXED, __HIP_MEMORY_SCOPE_WORKGROUP); r1 = __hip_atomic_fetch_add(lcnt + e1, 1u, __ATOMIC_RELAXED, __HIP_MEMORY_SCOPE_WORKGROUP);
    }
    __syncthreads();
    if (tid < 32) { const unsigned c = lcnt[tid]; lbase[tid] = c ? atomicAdd(cnt + 64 * tid, c) : 0u; }
    __syncthreads();
    if (tid < nrows) { const size_t row = (size_t)row_first + (size_t)(tid >> 4) * row_stride + (tid & 15);
        u32x4 a; a.x = (unsigned)e0; a.y = lbase[e0] + r0; a.z = __float_as_uint(w0); a.w = (unsigned)e1; u32x4 c2; c2.x = lbase[e1] + r1; c2.y = __float_as_uint(w1); c2.z = 0u; c2.w = 0u;
        *(u32x4*)(tok + row * 8) = a; *(u32x4*)(tok + row * 8 + 4) = c2; }
    __syncthreads();
}
__device__ __forceinline__ int expert_offsets(const Params& p, int lane, int& padded, int& tot, int& cnt_out) {
    const unsigned* cnt = (const unsigned*)(p.ws + WS_CTL) + CW_CNT;
    const int ce = (int)__hip_atomic_load(cnt + 64 * (lane & 31), __ATOMIC_RELAXED, __HIP_MEMORY_SCOPE_AGENT);
    cnt_out = ce; padded = (ce + 255) & ~255; int off = 0, total = 0;
#pragma unroll
    for (int e = 0; e < 32; ++e) { const int pe = __builtin_amdgcn_readlane(padded, e); if (e < (lane & 31)) off += pe; total += pe; }
    tot = total;
    return off;
}
__device__ __forceinline__ void p8_rows(const Params& p, int gw, int NGW, int lane) {
    unsigned* tok = (unsigned*)(p.ws + WS_TOK); float* wslot = (float*)(p.ws + WS_WSLOT); int* s2t = (int*)(p.ws + WS_S2T);
    int padded, tot, ce; const int off = expert_offsets(p, lane, padded, tot, ce);
    for (int base = gw * 64; base < MTOK; base += NGW * 64) { const int row = base + lane;
        const u32x4 a = *(const u32x4*)(tok + (size_t)row * 8); const u32x4 c2 = *(const u32x4*)(tok + (size_t)row * 8 + 4);
        const int s0 = __builtin_amdgcn_ds_bpermute((int)a.x << 2, off) + (int)a.y, s1 = __builtin_amdgcn_ds_bpermute((int)a.w << 2, off) + (int)c2.x;
        tok[(size_t)row * 8 + 6] = (unsigned)s0; tok[(size_t)row * 8 + 7] = (unsigned)s1; wslot[s0] = __uint_as_float(a.z); wslot[s1] = __uint_as_float(c2.y);
        s2t[s0] = row; s2t[s1] = row; }
    for (int e = gw; e < NEXP; e += NGW) {
        const int o = __builtin_amdgcn_ds_bpermute(e << 2, off), c = __builtin_amdgcn_ds_bpermute(e << 2, ce), pd = __builtin_amdgcn_ds_bpermute(e << 2, padded);
        for (int i = c + lane; i < pd; i += 64) s2t[o + i] = 0; }
}
__device__ __forceinline__ void build_tile_table(const Params& p, LAS unsigned char* lds, int tid, int lane) {
    LAS int* tx = (LAS int*)(lds + TEXP_OFF);
    if (tid < 64) { int padded, tot, ce_; const int off = expert_offsets(p, lane, padded, tot, ce_);
        if (lane < 32) { const int t0 = off >> 8, nt = padded >> 8; for (int t = 0; t < nt; ++t) tx[1 + t0 + t] = lane; }
        if (lane == 0) tx[0] = tot >> 8; }
    __syncthreads();
}
template <bool GATH> struct MoeSched {
    static constexpr bool GATHER = GATH, COLMAP64 = false;
    const char* A; const char* W; const LAS int* tx; const int* s2t; int lda2x256, wtile, ntn, G, c;
    __device__ __forceinline__ bool next(int i, pg8::Unit& u) const {
        const int T = __builtin_amdgcn_readfirstlane(tx[0]);
        int t, nt;
        if ((G & 7) == 0) {
            const int x = c & 7, w = c >> 3, wpx = G >> 3, TPX = (T + 7) >> 3, li = i * wpx + w;
            const int j = li / ntn; nt = li - j * ntn; t = x * TPX + j; if (j >= TPX || t >= T) return false;
        } else { const int L = i * G + c; t = L / ntn; nt = L - t * ntn; if (t >= T) return false; }
        const int e = __builtin_amdgcn_readfirstlane(tx[1 + t]);
        u.a = GATH ? A : A + (size_t)t * lda2x256; u.b = W + (size_t)(e * ntn + nt) * wtile; u.i0 = t; u.i1 = nt; u.i2 = e; u.i3 = 0; return true;
    }
    __device__ __forceinline__ void rows(const pg8::Unit& u, const int (&R)[2], const int (&C)[2], unsigned (&g0)[2], unsigned (&g1)[2]) const {
        const int* l = s2t + u.i0 * 256;
#pragma unroll
        for (int i = 0; i < 2; ++i) { const unsigned t0 = (unsigned)l[R[i]], t1 = (unsigned)l[128 + R[i]]; g0[i] = t0 * (unsigned)DM + (unsigned)C[i] * 2u; g1[i] = t1 * (unsigned)DM + (unsigned)C[i] * 2u; }
    }
};
struct EpiGateUp {
    static constexpr bool PERM = true, CHAIN = false, AFTER_DRAIN = false;
    unsigned char* act;
    __device__ __forceinline__ void operator()(const f32x4 (&acc)[2][2][4][2], const pg8::Unit& u, int wr, int wc, int fr, int fq) const {
        asm volatile("" : "+v"(fr), "+v"(fq));
        const int col0 = 128 * u.i1 + 32 * wc + 8 * fq; const float ws = 1.0f / W8_SCALE;
#pragma unroll
        for (int ai = 0; ai < 2; ++ai)
#pragma unroll
            for (int m = 0; m < 4; ++m) { const size_t slot = (size_t)256 * u.i0 + 128 * ai + 64 * wr + 16 * m + fr;
                float r[8];
#pragma unroll
                for (int n = 0; n < 2; ++n)
#pragma unroll
                    for (int e = 0; e < 4; ++e) r[4 * n + e] = silu_f(acc[ai][0][m][n][e] * ws) * (acc[ai][1][m][n][e] * (ws * A8_SCALE));
                *(u32x2*)(act + slot * FF + col0) = cvt8_fp8(r); }
    }
};
struct EpiDown {
    static constexpr bool PERM = true, CHAIN = false, AFTER_DRAIN = false;
    bf16_t* y; const float* wslot;
    __device__ __forceinline__ void operator()(const f32x4 (&acc)[2][2][4][2], const pg8::Unit& u, int wr, int wc, int fr, int fq) const {
        asm volatile("" : "+v"(fr), "+v"(fq));
        const int col0 = 256 * u.i1 + 32 * wc + 8 * fq;
        float wsv[2][4];
#pragma unroll
        for (int ai = 0; ai < 2; ++ai)
#pragma unroll
            for (int m = 0; m < 4; ++m) wsv[ai][m] = wslot[(size_t)256 * u.i0 + 128 * ai + 64 * wr + 16 * m + fr];
#pragma unroll
        for (int ai = 0; ai < 2; ++ai)
#pragma unroll
            for (int m = 0; m < 4; ++m) { const size_t slot = (size_t)256 * u.i0 + 128 * ai + 64 * wr + 16 * m + fr; const float ws_ = wsv[ai][m] * (1.0f / (W8_SCALE * A8_SCALE));
#pragma unroll
                for (int bj = 0; bj < 2; ++bj) { const f32x4 v0 = acc[ai][bj][m][0] * ws_, v1 = acc[ai][bj][m][1] * ws_;
                    u32x4 w; w.x = cvt_pk_bf16(v0[0], v0[1]); w.y = cvt_pk_bf16(v0[2], v0[3]); w.z = cvt_pk_bf16(v1[0], v1[1]); w.w = cvt_pk_bf16(v1[2], v1[3]);
                    *(u32x4*)(y + slot * DM + col0 + 128 * bj) = w; } }
    }
};
__device__ __forceinline__ void p11_rows(const Params& p, int gw, int NGW, int lane) {
    const float* mod = (const float*)(p.ws + WS_MOD); const bf16_t* X1 = (const bf16_t*)(p.ws + WS_X1); const bf16_t* Y = (const bf16_t*)(p.ws + WS_Y); const unsigned* tok = (const unsigned*)(p.ws + WS_TOK);
    for (int row = gw; row < MTOK; row += NGW) {
        const int b = row >> 12;
        const u32x4* xr = (const u32x4*)(X1 + (size_t)row * DM) + lane;
        float v[4][8]; float s = 0.f;
#if DBG_MODE == 1
#pragma unroll
        for (int j = 0; j < 4; ++j) { const u32x4 w = xr[64 * j]; v[j][0] = bflo(w.x); v[j][1] = bfhi(w.x); v[j][2] = bflo(w.y); v[j][3] = bfhi(w.y); v[j][4] = bflo(w.z); v[j][5] = bfhi(w.z); v[j][6] = bflo(w.w); v[j][7] = bfhi(w.w); }
#else
        const int s0 = (int)tok[(size_t)row * 8 + 6], s1 = (int)tok[(size_t)row * 8 + 7];
        const u32x4* y0 = (const u32x4*)(Y + (size_t)s0 * DM) + lane; const u32x4* y1 = (const u32x4*)(Y + (size_t)s1 * DM) + lane;
#pragma unroll
        for (int j = 0; j < 4; ++j) { const int c8 = 2 * (64 * j + lane); const u32x4 w = __builtin_nontemporal_load(xr + 64 * j), a = __builtin_nontemporal_load(y0 + 64 * j), c2 = __builtin_nontemporal_load(y1 + 64 * j);
            const f32x4 g0 = ((const f32x4*)(mod + b * 12288 + 5 * 2048))[c8], g1 = ((const f32x4*)(mod + b * 12288 + 5 * 2048))[c8 + 1];
            v[j][0] = bflo(w.x) + g0[0] * (bflo(a.x) + bflo(c2.x)); v[j][1] = bfhi(w.x) + g0[1] * (bfhi(a.x) + bfhi(c2.x));
            v[j][2] = bflo(w.y) + g0[2] * (bflo(a.y) + bflo(c2.y)); v[j][3] = bfhi(w.y) + g0[3] * (bfhi(a.y) + bfhi(c2.y));
            v[j][4] = bflo(w.z) + g1[0] * (bflo(a.z) + bflo(c2.z)); v[j][5] = bfhi(w.z) + g1[1] * (bfhi(a.z) + bfhi(c2.z));
            v[j][6] = bflo(w.w) + g1[2] * (bflo(a.w) + bflo(c2.w)); v[j][7] = bfhi(w.w) + g1[3] * (bfhi(a.w) + bfhi(c2.w)); }
#endif
#pragma unroll
        for (int j = 0; j < 4; ++j)
#pragma unroll
            for (int e = 0; e < 8; ++e) s += v[j][e] * v[j][e];
        const float rstd = 1.0f / sqrtf(wave_sum(s) * (1.0f / DM) + NORM_EPS);
        f32x4* orow = (f32x4*)(p.out + (size_t)row * DM);
#pragma unroll
        for (int j = 0; j < 4; ++j) { const int c8 = 2 * (64 * j + lane); const f32x4 f0 = ((const f32x4*)p.final_norm_w)[c8], f1 = ((const f32x4*)p.final_norm_w)[c8 + 1];
            __builtin_nontemporal_store((f32x4){v[j][0] * rstd * f0[0], v[j][1] * rstd * f0[1], v[j][2] * rstd * f0[2], v[j][3] * rstd * f0[3]}, orow + c8);
            __builtin_nontemporal_store((f32x4){v[j][4] * rstd * f1[0], v[j][5] * rstd * f1[1], v[j][6] * rstd * f1[2], v[j][7] * rstd * f1[3]}, orow + c8 + 1); }
    }
}

constexpr int NCHAIN = 32;
__global__ void __launch_bounds__(NWAVES * 64, 2) fwd_megakernel(Params p) {
    extern __shared__ __attribute__((aligned(16))) unsigned char lds_raw[];
    LAS unsigned char* lds = (LAS unsigned char*)lds_raw;
    const int G = gridDim.x, bx = blockIdx.x;
    const int vcu = (G % 8 == 0) ? (bx % 8) * (G / 8) + bx / 8 : bx;
    const int NGW = G * NWAVES;
    const int wave_s = __builtin_amdgcn_readfirstlane((int)threadIdx.x >> 6);
#define FRESH_IDS() int lane; asm volatile("v_mbcnt_lo_u32_b32 %0, -1, 0\n\tv_mbcnt_hi_u32_b32 %0, -1, %0" : "=v"(lane)); const int wave = wave_s, tid = wave * 64 + lane, gw = vcu * NWAVES + wave; (void)tid; (void)gw
    volatile LAS unsigned* MISC = (volatile LAS unsigned*)(lds + MISC_OFF);
    { FRESH_IDS(); for (int u = tid; u < (LDS_BYTES - CTL_OFF) / 4; u += NWAVES * 64) ((LAS unsigned*)(lds + CTL_OFF))[u] = 0u; }
    __syncthreads();
    unsigned* ctl = (unsigned*)(p.ws + WS_CTL);
    XcdBarrier bar = xcd_barrier_post(ctl + CW_BAR, MISC + 8);

    _Pragma("unroll 1") for (int rep_ = 0; rep_ < ((REP & 1) ? 2 : 1); ++rep_) {
    if (PHASES & 1) { FRESH_IDS(); if (bx < 192) p0_mod_item(p, lds, bx, tid, wave, lane);
        { float* WrT = (float*)(p.ws + WS_WRT); for (int idx = gw * 64 + lane; idx < 48 * 2048; idx += NGW * 64) { const int c = idx >> 11, k = idx & 2047;
            WrT[idx] = c < 4 ? p.w_rg[k * 4 + c] : (c < 16 ? 0.f : p.w_re[((size_t)((c - 16) >> 3) * DM + k) * 8 + ((c - 16) & 7)]); } }
        conv_range(p, lds, 0, CV_P3, gw, NGW, wave, lane);
        if (wave == 0) { unsigned* rdy = (unsigned*)(p.ws + WS_CTL) + CW_MODRDY; unsigned sp = 0;
            while ((unsigned)__builtin_amdgcn_readfirstlane(__hip_atomic_load(rdy, __ATOMIC_RELAXED, __HIP_MEMORY_SCOPE_AGENT)) < 192u && ++sp < (1u << 22)) __builtin_amdgcn_s_sleep(2);
            __builtin_amdgcn_fence(__ATOMIC_ACQUIRE, "agent"); asm volatile("s_waitcnt vmcnt(0)" ::: "memory"); }
        __syncthreads(); }
    }
    _Pragma("unroll 1") for (int rep_ = 0; rep_ < ((REP & 2) ? 2 : 1); ++rep_) {
    if (PHASES & 2) { FRESH_IDS(); p1_rows(p, gw, NGW, lane); }
    xcd_barrier(bar);
    }
    _Pragma("unroll 1") for (int rep_ = 0; rep_ < ((REP & 4) ? 2 : 1); ++rep_) {
    if (PHASES & 4) {
        InProjSched S{(const char*)(p.ws + WS_HX), (const char*)(p.ws + WS_WIN), G, bx};
        EpiInProj E{p.ws, p.ret_decay_f, p.ret_decay_b};
        pg8::gemm_phase<EpiInProj, InProjSched, true>(lds, wave_s, DM, DM, DM, S, E);
        InProjSched8 S8{(const char*)(p.ws + WS_X1), (const char*)(p.ws + WS_WIN), G - 16, bx - 16};
        pg8::gemm_phase<EpiInProj, InProjSched8, true, 1>(lds, wave_s, DM, DM, DM / 2, S8, E);
        if (rep_ == 0 && bx >= 176 && G == 256) { FRESH_IDS(); conv_range(p, lds, CV_P0, CV_P2, (bx - 176) * NWAVES + wave, 80 * NWAVES, wave, lane); }
        else if (rep_ == 0 && G != 256) { FRESH_IDS(); conv_range(p, lds, CV_P0, CV_P2, gw, NGW, wave, lane); }
    }
    xcd_barrier(bar);
    }
    _Pragma("unroll 1") for (int rep_ = 0; rep_ < ((REP & 24) ? 2 : 1); ++rep_) {
    if (bx < NCHAIN) {
        if ((PHASES & 16) && (rep_ == 0 || (REP & 16))) {
        const int rh = bx & 1, dir = (bx >> 1) & 1, bh = bx >> 2, h = bh & 3;
        const char* svp = (const char*)(p.ws + WS_SV) + ((size_t)bh * 16 * 256 * 768 + (size_t)rh * 128 * 768 + 512) * 2;
        const char* svcp = (const char*)(p.ws + WS_SVC) + ((size_t)bh * 256 * 768 + (size_t)rh * 128 * 768 + 512) * 2;
        const char* kTp = (const char*)(p.ws + (dir == 0 ? WS_KTF : WS_KTB)) + (size_t)bh * 256 * LDT * 2;
        ChainSched S{svp, svcp, kTp, dir};
        const float lg = log2_sigmoid(dir == 0 ? p.ret_decay_f[h] : p.ret_decay_b[h]);
        EpiChain E{(bf16_t*)(p.ws + WS_SV) + (size_t)bh * 16 * 256 * 768 + (size_t)rh * 128 * 768, dir, exp2f(lg * 256.0f)};
        pg8::gemm_phase<EpiChain, ChainSched, true, 0, 1>(lds, wave_s, 768, LDT, 256, S, E); }
    } else {
#if DBG_MODE != 3
        if ((PHASES & 32) && rep_ == 0) {
            ScoreSched S{(const char*)(p.ws + WS_Q), (const char*)(p.ws + WS_K), bx < NCHAIN + 128 ? bx - NCHAIN : -1};
            EpiScore E{(bf16_t*)(p.ws + WS_QP), p.ret_decay_f, p.ret_decay_b};
            pg8::gemm_phase<EpiScore, ScoreSched, true>(lds, wave_s, 1024, 1024, 256, S, E); }
        if ((PHASES & 8) && (rep_ == 0 || (REP & 8))) { FRESH_IDS();
        if (G == 256) {
            const int xl = bx & 7, vl = (bx >> 3) - NCHAIN / 8; na_wg_items(p, lds, 128 * xl + vl, 128 * xl + 128, 32 - NCHAIN / 8, wave, lane);
            if (rep_ == 0) conv_range(p, lds, CV_P3, CV_P0, (bx - NCHAIN) * NWAVES + wave, (256 - NCHAIN) * NWAVES, wave, lane);
        } else { na_wg_items(p, lds, bx - NCHAIN, 1024, G - NCHAIN, wave, lane);
            if (rep_ == 0) conv_range(p, lds, CV_P3, CV_P0, (bx - NCHAIN) * NWAVES + wave, (G - NCHAIN) * NWAVES, wave, lane); } }
#endif
    }
    xcd_barrier(bar);
    }
    _Pragma("unroll 1") for (int rep_ = 0; rep_ < ((REP & 32) ? 2 : 1); ++rep_) {
#if DBG_MODE != 2
    if (PHASES & 32) {
        RetOutSched S{(const char*)(p.ws + WS_QP), (const char*)(p.ws + WS_SV), bx < 128 ? bx : -1};
        EpiRetOut E{(const bf16_t*)(p.ws + WS_G), p.ret_gn_w, (bf16_t*)(p.ws + WS_MIX)};
        pg8::gemm_phase<EpiRetOut, RetOutSched, true>(lds, wave_s, 768, 768, 768, S, E);
        if (rep_ == 0 && bx >= 128 && G == 256) { FRESH_IDS(); conv_range(p, lds, CV_P2, CV_P9, (bx - 128) * NWAVES + wave, 128 * NWAVES, wave, lane); }
        else if (rep_ == 0 && G != 256) { FRESH_IDS(); conv_range(p, lds, CV_P2, CV_P9, gw, NGW, wave, lane); } }
#endif
    xcd_barrier(bar);
    }
    _Pragma("unroll 1") for (int rep_ = 0; rep_ < ((REP & 64) ? 2 : 1); ++rep_) {
    if (PHASES & 64) {
        OutProjSched S{(const char*)(p.ws + WS_MIX), (const char*)(p.ws + WS_WOUT), G, bx};
        EpiOutProj E{p.x, (const float*)(p.ws + WS_MOD), (bf16_t*)(p.ws + WS_X1)};
        pg8::gemm_phase<EpiOutProj, OutProjSched, true, 1>(lds, wave_s, DM, DM, DM / 2, S, E);
    }
    xcd_barrier(bar);
    }
#if DBG_MODE != 1
    _Pragma("unroll 1") for (int rep_ = 0; rep_ < ((REP & 128) ? 2 : 1); ++rep_) {
    if (PHASES & 128) { FRESH_IDS(); if (tid < 32) ((LAS unsigned*)(lds + 156160 + 4608))[tid] = 0u;
        int slot = 0; for (int item = bx; item < 512 && slot < 2; item += G, ++slot) p7_item(p, lds, item, slot, tid, wave, lane);
        p7_finish(p, lds, 16 * bx, 16 * G, 16 * slot, tid, ((REP & 128) && rep_ == 0) ? 4096 : 0); }
    xcd_barrier(bar);
    }
    _Pragma("unroll 1") for (int rep_ = 0; rep_ < ((REP & 256) ? 2 : 1); ++rep_) {
    if (PHASES & 256) { FRESH_IDS(); p8_rows(p, gw, NGW, lane);
        build_tile_table(p, lds, tid, lane); }
    xcd_barrier(bar);
    }
    _Pragma("unroll 1") for (int rep_ = 0; rep_ < ((REP & 512) ? 2 : 1); ++rep_) {
    if (PHASES & 512) {
        MoeSched<true> S{(const char*)(p.ws + WS_HF), (const char*)(p.ws + WS_WGU), (const LAS int*)(lds + TEXP_OFF), (const int*)(p.ws + WS_S2T), 256 * DM, 256 * DM, 4, G, bx};
        EpiGateUp E{p.ws + WS_ACT};
        pg8::gemm_phase<EpiGateUp, MoeSched<true>, true, 1>(lds, wave_s, DM / 2, DM / 2, DM / 2, S, E);
        if (rep_ == 0) { FRESH_IDS(); const int T9 = ((const LAS int*)(lds + TEXP_OFF))[0];
            if ((G & 7) == 0) { const int wpx = G >> 3, TPX = (T9 + 7) >> 3, x = bx & 7, w = bx >> 3; int before = 0, total = 0, hw_me = 0;
                for (int xx = 0; xx < 8; ++xx) { const int tiles = min(max(T9 - xx * TPX, 0), TPX), hw = min(max(4 * tiles - wpx, 0), wpx); if (xx < x) before += wpx - hw; if (xx == x) hw_me = hw; total += wpx - hw; }
                if (total == 0) conv_range(p, lds, CV_P9, NCONV, gw, NGW, wave, lane);
                else if (w >= hw_me) conv_range(p, lds, CV_P9, NCONV, (before + w - hw_me) * NWAVES + wave, total * NWAVES, wave, lane);
            } else { const int n9 = 4 * T9, heavy = min(max(n9 - G, 0), G - 1); if (bx >= heavy) conv_range(p, lds, CV_P9, NCONV, (bx - heavy) * NWAVES + wave, (G - heavy) * NWAVES, wave, lane); } }
    }
    xcd_barrier(bar);
    }
    _Pragma("unroll 1") for (int rep_ = 0; rep_ < ((REP & 1024) ? 2 : 1); ++rep_) {
    if (PHASES & 1024) {
        MoeSched<false> S{(const char*)(p.ws + WS_ACT), (const char*)(p.ws + WS_WD), (const LAS int*)(lds + TEXP_OFF), nullptr, 256 * FF, 256 * FF, 8, G, bx};
        EpiDown E{(bf16_t*)(p.ws + WS_Y), (const float*)(p.ws + WS_WSLOT)};
        pg8::gemm_phase<EpiDown, MoeSched<false>, true, 1>(lds, wave_s, FF / 2, FF / 2, FF / 2, S, E);
    }
    xcd_barrier(bar);
    }
#endif
    _Pragma("unroll 1") for (int rep_ = 0; rep_ < ((REP & 2048) ? 2 : 1); ++rep_) {
    if (PHASES & 2048) { FRESH_IDS(); p11_rows(p, gw, NGW, lane); }
    }
#undef FRESH_IDS
}

extern "C" void kernel_launch(void* const* d_in, const int* in_sizes, int n_in, void* d_out, int out_size, void* d_ws, size_t ws_size, hipStream_t stream) {
    static int grid = 0;
    if (grid == 0) {
        if (n_in != 22 || ws_size < WS_END) { fprintf(stderr, "kernel_launch: unexpected inputs (n_in %d, ws %zu, need %zu)\n", n_in, ws_size, (size_t)WS_END); grid = -1; return; }
        int dev = 0, cus = 0;
        if (hipGetDevice(&dev) != hipSuccess || hipDeviceGetAttribute(&cus, hipDeviceAttributeMultiprocessorCount, dev) != hipSuccess) { grid = -1; return; }
        if (hipFuncSetAttribute((const void*)fwd_megakernel, hipFuncAttributeMaxDynamicSharedMemorySize, LDS_BYTES) != hipSuccess) { fprintf(stderr, "kernel_launch: hipFuncSetAttribute failed\n"); grid = -1; return; }
        (void)hipGetLastError();
        grid = cus;
    }
    if (grid < 0) return;
    (void)hipMemsetAsync((char*)d_ws + WS_CTL, 0, CTL_ZERO_BYTES, stream);
    Params p{};
    const float** pp = (const float**)&p;
    for (int i = 0; i < 22; ++i) pp[i] = (const float*)d_in[i];
    p.out = (float*)d_out; p.ws = (unsigned char*)d_ws;
    hipLaunchKernelGGL(fwd_megakernel, dim3(grid), dim3(NWAVES * 64), LDS_BYTES, stream, p);
}
```
